# Optimizing an MI355X kernel written in HIP

```python
import math
import jax, jax.numpy as jnp
from jax import lax
import numpy as np

D_MODEL = 1024
BATCH = 16
SEQ = 4096
DEPTH = 1

CONV_WIDTH = D_MODEL
CONV_K = 3
DA_HEADS = 8
DA_HEAD_DIM = 64
DA_VALUE_DIM = 2 * DA_HEAD_DIM
DA_WIDTH = DA_HEADS * DA_VALUE_DIM
Q_BLOCK = 128
COLS_CONV = 4 * CONV_WIDTH
COLS_ATTN = 3 * DA_WIDTH + DA_WIDTH
COLS_GATE = 2 * D_MODEL
IN_COLS = COLS_CONV + COLS_ATTN + COLS_GATE
NORM_EPS = 1e-6
HEAD_NORM_EPS = 1e-5

kernel_name = "hybrid_shortconv_diffattn_gated_merge"


def rms_norm(x, w, eps):
    xf = x.astype(jnp.float32)
    y = xf * lax.rsqrt(jnp.mean(xf * xf, axis=-1, keepdims=True) + eps)
    return (y * w.astype(jnp.float32)).astype(x.dtype)


def lambda_init(layer_idx):
    return 0.8 - 0.6 * math.exp(-0.3 * layer_idx)


def causal_short_conv(u, w):
    k = w.shape[0]
    s = u.shape[1]
    up = jnp.pad(u, ((0, 0), (k - 1, 0), (0, 0)))
    y = up[:, 0:s] * w[0]
    for j in range(1, k):
        y = y + up[:, j:j + s] * w[j]
    return y


def short_conv_branch(xa, c, b, z, conv_w, w_out):
    u = causal_short_conv(c * xa, conv_w)
    return (jax.nn.silu(z) * b * u) @ w_out


def diff_attention(q, k, v, lam):
    s_len = q.shape[1]
    scale = DA_HEAD_DIM ** -0.5
    qh = jnp.transpose(q, (0, 2, 3, 1, 4))
    kh = jnp.transpose(k, (0, 2, 3, 1, 4))
    vh = jnp.transpose(v, (0, 2, 1, 3))
    outs = []
    for i in range(s_len // Q_BLOCK):
        lo, hi = i * Q_BLOCK, (i + 1) * Q_BLOCK
        qb = qh[:, :, :, lo:hi]
        kb = kh[:, :, :, :hi]
        vb = vh[:, :, :hi]
        sc = jnp.einsum('bhcqd,bhckd->bhcqk', qb, kb).astype(jnp.float32) * scale
        mask = jnp.arange(hi)[None, :] <= jnp.arange(lo, hi)[:, None]
        sc = jnp.where(mask, sc, -jnp.inf)
        p = jax.nn.softmax(sc, axis=-1)
        attn = p[:, :, 0] - lam * p[:, :, 1]
        outs.append(jnp.einsum('bhqk,bhkd->bhqd', attn.astype(v.dtype), vb))
    o = jnp.concatenate(outs, axis=2)
    return jnp.transpose(o, (0, 2, 1, 3))


def diff_attention_branch(q, k, v, z, lq1, lk1, lq2, lk2, head_norm_w, w_out, layer_idx):
    bsz, s_len = q.shape[0], q.shape[1]
    lam_init = lambda_init(layer_idx)
    lam = (jnp.exp(jnp.sum(lq1.astype(jnp.float32) * lk1.astype(jnp.float32)))
           - jnp.exp(jnp.sum(lq2.astype(jnp.float32) * lk2.astype(jnp.float32)))
           + lam_init)
    q = q.reshape(bsz, s_len, DA_HEADS, 2, DA_HEAD_DIM)
    k = k.reshape(bsz, s_len, DA_HEADS, 2, DA_HEAD_DIM)
    v = v.reshape(bsz, s_len, DA_HEADS, DA_VALUE_DIM)
    o = diff_attention(q, k, v, lam)
    o = rms_norm(o, head_norm_w, HEAD_NORM_EPS) * (1.0 - lam_init)
    o = o.reshape(bsz, s_len, DA_WIDTH)
    return (jax.nn.silu(z) * o) @ w_out


def setup_inputs(seed: int = 0) -> dict:
    key = jax.random.key(seed)
    ks = jax.random.split(key, 16)
    f32 = jnp.float32
    x = jax.random.normal(ks[0], (BATCH, SEQ, D_MODEL), f32)
    norm_w = 1.0 + 0.02 * jax.random.normal(ks[1], (DEPTH, D_MODEL), f32)
    w_in = jax.random.normal(ks[2], (DEPTH, D_MODEL, IN_COLS), f32) * D_MODEL ** -0.5
    conv_w = jax.random.normal(ks[3], (DEPTH, CONV_K, CONV_WIDTH), f32) * CONV_K ** -0.5
    w_out_a = jax.random.normal(ks[4], (DEPTH, CONV_WIDTH, D_MODEL), f32) * CONV_WIDTH ** -0.5
    lambda_q1 = 0.1 * jax.random.normal(ks[5], (DEPTH, DA_HEAD_DIM), f32)
    lambda_k1 = 0.1 * jax.random.normal(ks[6], (DEPTH, DA_HEAD_DIM), f32)
    lambda_q2 = 0.1 * jax.random.normal(ks[7], (DEPTH, DA_HEAD_DIM), f32)
    lambda_k2 = 0.1 * jax.random.normal(ks[8], (DEPTH, DA_HEAD_DIM), f32)
    head_norm_w = 1.0 + 0.02 * jax.random.normal(ks[9], (DEPTH, DA_VALUE_DIM), f32)
    w_out_b = jax.random.normal(ks[10], (DEPTH, DA_WIDTH, D_MODEL), f32) * DA_WIDTH ** -0.5
    b_gate = 0.02 * jax.random.normal(ks[11], (DEPTH, COLS_GATE), f32)
    w_o = jax.random.normal(ks[12], (DEPTH, D_MODEL, D_MODEL), f32) * D_MODEL ** -0.5
    final_norm_w = 1.0 + 0.02 * jax.random.normal(ks[13], (D_MODEL,), f32)
    return {"x": x, "norm_w": norm_w, "w_in": w_in, "conv_w": conv_w, "w_out_a": w_out_a,
            "lambda_q1": lambda_q1, "lambda_k1": lambda_k1, "lambda_q2": lambda_q2,
            "lambda_k2": lambda_k2, "head_norm_w": head_norm_w, "w_out_b": w_out_b,
            "b_gate": b_gate, "w_o": w_o, "final_norm_w": final_norm_w}


def reference(x, norm_w, w_in, conv_w, w_out_a, lambda_q1, lambda_k1, lambda_q2, lambda_k2,
              head_norm_w, w_out_b, b_gate, w_o, final_norm_w):
    c0 = 0
    c1 = c0 + COLS_CONV
    c2 = c1 + COLS_ATTN
    for layer in range(DEPTH):
        h = rms_norm(x, norm_w[layer], NORM_EPS)
        proj = h @ w_in[layer]
        xa, cg, bg, za = jnp.split(proj[..., c0:c1], 4, axis=-1)
        q, k, v, zb = jnp.split(proj[..., c1:c2], 4, axis=-1)
        gates = jax.nn.sigmoid(proj[..., c2:] + b_gate[layer])
        g_a, g_b = jnp.split(gates, 2, axis=-1)
        y_a = short_conv_branch(xa, cg, bg, za, conv_w[layer], w_out_a[layer])
        y_b = diff_attention_branch(q, k, v, zb, lambda_q1[layer], lambda_k1[layer],
                                    lambda_q2[layer], lambda_k2[layer], head_norm_w[layer],
                                    w_out_b[layer], layer)
        x = x + (g_a * y_a + g_b * y_b) @ w_o[layer]
    return rms_norm(x, final_norm_w, NORM_EPS)
```

```cpp
#include <hip/hip_runtime.h>
#include <cstdio>
#include <cstdint>
#include <hip/hip_cooperative_groups.h>
namespace pg8 {
#define PG8_LAS __attribute__((address_space(3)))
typedef unsigned short bf16_t;
typedef short bf16x8 __attribute__((ext_vector_type(8)));
typedef float f32x4 __attribute__((ext_vector_type(4)));
typedef unsigned u32x4 __attribute__((ext_vector_type(4)));
constexpr int BM = 256, BK = 64, HALF = 128, HTB = HALF * BK * 2  , STAGE_BYTES = 8 * HTB, NXCD = 8, WGM = 8;

__host__ __device__ __forceinline__ int lds_byte(int r, int c) { const int st = (r >> 4) * 2 + (c >> 5), rr = r & 15, cc = c & 31, ob = rr * 64 + cc * 2; return st * 1024 + (ob ^ (((ob >> 9) & 1) << 5)); }
__host__ __device__ __forceinline__ void stage_rc(int b, int& R, int& C) { const int st = b / 1024, sb = b % 1024, swz = sb ^ (((sb >> 9) & 1) << 5); R = (st >> 1) * 16 + swz / 64; C = (st & 1) * 32 + (swz % 64) / 2; }
__host__ __device__ __forceinline__ int perm32(int rho) { const int n = rho >> 4, i = rho & 15; return 8 * (i >> 2) + 4 * n + (i & 3); }

struct Unit { int pm, pn; };
struct Gemm { const bf16_t* A; const bf16_t* Bt; int M, N, K; };

struct StaticOrder {
    int nM, nN, nwg, G, c;
    __host__ __device__ void init(int M, int N, int G_, int c_) { nM = M / BM; nN = N / BM; nwg = nM * nN; G = G_; c = c_; }
    __host__ __device__ bool next(int i, Unit& u) const {
        const long L = (long)i * G + c; if (L >= nwg) return false;
        int wgid = (int)L; { const int q = nwg / NXCD, r = nwg % NXCD, xcd = wgid % NXCD, off = wgid / NXCD; wgid = (xcd < r ? xcd * (q + 1) : r * (q + 1) + (xcd - r) * q) + off; }
        const int nig = WGM * nN, gid = wgid / nig, fm = gid * WGM, gsz = (nM - fm) < WGM ? (nM - fm) : WGM;
        u.pm = fm + ((wgid % nig) % gsz); u.pn = (wgid % nig) / gsz; return true;
    }
    __device__ __forceinline__ void a_ready(const Unit&) const {}
    __device__ __forceinline__ void done(const Unit&) const {}
};

typedef float cvt_f32x2_t __attribute__((ext_vector_type(2))); typedef __bf16 cvt_bf16x2_t __attribute__((ext_vector_type(2)));
__device__ __forceinline__ unsigned cvt_pk_bf16(float lo, float hi) { cvt_f32x2_t v = {lo, hi}; cvt_bf16x2_t b = __builtin_convertvector(v, cvt_bf16x2_t); return __builtin_bit_cast(unsigned, b); }
typedef float f32x2 __attribute__((ext_vector_type(2)));
__device__ __forceinline__ float sigmoid_f(float x) { return __builtin_amdgcn_rcpf(1.0f + __builtin_amdgcn_exp2f(-1.4426950408889634f * x)); }
__device__ __forceinline__ float silu_f(float x) { return x * sigmoid_f(x); }
__device__ __forceinline__ float bf_lo(unsigned w) { return __builtin_bit_cast(float, w << 16); }
__device__ __forceinline__ float bf_hi(unsigned w) { return __builtin_bit_cast(float, w & 0xffff0000u); }
typedef unsigned u32x2 __attribute__((ext_vector_type(2)));

struct EpiInProj {
    static constexpr bool PERM = true, AFTER_DRAIN = false;
    bf16_t* CX; bf16_t* SB; bf16_t* QKVZ; size_t stride; bf16_t* GT; const float* bgate; float qscale;
    __device__ __forceinline__ void operator()(const f32x4 (&acc)[2][2][4][2], const Unit& u, int wr, int wc, int fr, int fq) const {
        const int row0 = u.pm * BM + wr * 64 + fr;
        if (u.pn < 16) {
            const int ch = u.pn * 64 + wc * 16 + fq * 4;
#pragma unroll
            for (int ai = 0; ai < 2; ++ai)
#pragma unroll
                for (int m = 0; m < 4; ++m) {
                    const size_t off = (size_t)(row0 + ai * HALF + m * 16) * 1024 + ch;
                    const f32x4 xa = acc[ai][0][m][0], cg = acc[ai][0][m][1], bg = acc[ai][1][m][0], za = acc[ai][1][m][1];
                    const f32x4 cx = xa * cg;
                    f32x4 sb; sb[0] = silu_f(za[0]) * bg[0]; sb[1] = silu_f(za[1]) * bg[1]; sb[2] = silu_f(za[2]) * bg[2]; sb[3] = silu_f(za[3]) * bg[3];
                    u32x2 w0, w1; w0.x = cvt_pk_bf16(cx[0], cx[1]); w0.y = cvt_pk_bf16(cx[2], cx[3]); w1.x = cvt_pk_bf16(sb[0], sb[1]); w1.y = cvt_pk_bf16(sb[2], sb[3]);
                    *(u32x2*)(CX + off) = w0; *(u32x2*)(SB + off) = w1;
                }
        } else if (u.pn < 32) {
            const int t = (u.pn - 16) >> 2; bf16_t* base = QKVZ + (size_t)t * stride; const float sc = (t == 0) ? qscale : 1.0f;
            const int col0 = ((u.pn - 16) & 3) * BM + wc * 32 + 8 * fq;
#pragma unroll
            for (int ai = 0; ai < 2; ++ai)
#pragma unroll
                for (int m = 0; m < 4; ++m) { bf16_t* rowp = base + (size_t)(row0 + ai * HALF + m * 16) * 1024 + col0;
#pragma unroll
                    for (int bj = 0; bj < 2; ++bj) { const f32x4 v0 = acc[ai][bj][m][0] * sc, v1 = acc[ai][bj][m][1] * sc;
                        u32x4 w; w.x = cvt_pk_bf16(v0[0], v0[1]); w.y = cvt_pk_bf16(v0[2], v0[3]); w.z = cvt_pk_bf16(v1[0], v1[1]); w.w = cvt_pk_bf16(v1[2], v1[3]);
                        *(u32x4*)(rowp + bj * HALF) = w; } }
        } else {
            const int col0 = (u.pn - 32) * BM + wc * 32 + 8 * fq;
            f32x4 bv[2][2];
#pragma unroll
            for (int bj = 0; bj < 2; ++bj)
#pragma unroll
                for (int n = 0; n < 2; ++n) bv[bj][n] = *(const f32x4*)(bgate + col0 + bj * HALF + 4 * n);
#pragma unroll
            for (int ai = 0; ai < 2; ++ai)
#pragma unroll
                for (int m = 0; m < 4; ++m) { bf16_t* rowp = GT + (size_t)(row0 + ai * HALF + m * 16) * 2048 + col0;
#pragma unroll
                    for (int bj = 0; bj < 2; ++bj) { const f32x4 a0 = acc[ai][bj][m][0] + bv[bj][0], a1 = acc[ai][bj][m][1] + bv[bj][1];
                        u32x4 w; w.x = cvt_pk_bf16(sigmoid_f(a0[0]), sigmoid_f(a0[1])); w.y = cvt_pk_bf16(sigmoid_f(a0[2]), sigmoid_f(a0[3]));
                        w.z = cvt_pk_bf16(sigmoid_f(a1[0]), sigmoid_f(a1[1])); w.w = cvt_pk_bf16(sigmoid_f(a1[2]), sigmoid_f(a1[3]));
                        *(u32x4*)(rowp + bj * HALF) = w; } }
        }
    }
};
template <bool PREV> struct EpiGate {
    static constexpr bool PERM = true, AFTER_DRAIN = false;
    bf16_t* O; const bf16_t* G; const bf16_t* P;
    __device__ __forceinline__ void operator()(const f32x4 (&acc)[2][2][4][2], const Unit& u, int wr, int wc, int fr, int fq) const {
        const int row0 = u.pm * BM + wr * 64 + fr, col0 = u.pn * BM + wc * 32 + 8 * fq;
#pragma unroll
        for (int ai = 0; ai < 2; ++ai) {
            u32x4 g[4][2], p[4][2];
#pragma unroll
            for (int m = 0; m < 4; ++m)
#pragma unroll
                for (int bj = 0; bj < 2; ++bj) { const size_t row = (size_t)(row0 + ai * HALF + m * 16); const int c = col0 + bj * HALF;
                    g[m][bj] = *(const u32x4*)(G + row * 2048 + c); if (PREV) p[m][bj] = *(const u32x4*)(P + row * 1024 + c); }
#pragma unroll
            for (int m = 0; m < 4; ++m)
#pragma unroll
                for (int bj = 0; bj < 2; ++bj) { const size_t row = (size_t)(row0 + ai * HALF + m * 16); const int c = col0 + bj * HALF;
                    const u32x4 gv = g[m][bj]; const f32x4 a0 = acc[ai][bj][m][0], a1 = acc[ai][bj][m][1];
                    float o[8] = {a0[0] * bf_lo(gv.x), a0[1] * bf_hi(gv.x), a0[2] * bf_lo(gv.y), a0[3] * bf_hi(gv.y), a1[0] * bf_lo(gv.z), a1[1] * bf_hi(gv.z), a1[2] * bf_lo(gv.w), a1[3] * bf_hi(gv.w)};
                    if (PREV) { const u32x4 pv = p[m][bj];
                        o[0] += bf_lo(pv.x); o[1] += bf_hi(pv.x); o[2] += bf_lo(pv.y); o[3] += bf_hi(pv.y); o[4] += bf_lo(pv.z); o[5] += bf_hi(pv.z); o[6] += bf_lo(pv.w); o[7] += bf_hi(pv.w); }
                    u32x4 w; w.x = cvt_pk_bf16(o[0], o[1]); w.y = cvt_pk_bf16(o[2], o[3]); w.z = cvt_pk_bf16(o[4], o[5]); w.w = cvt_pk_bf16(o[6], o[7]);
                    *(u32x4*)(O + row * 1024 + c) = w; }
            asm volatile("" ::: "memory"); }
    }
};
struct EpiResF32 {
    static constexpr bool PERM = true, AFTER_DRAIN = false;
    float* O; const float* X;
    __device__ __forceinline__ void operator()(const f32x4 (&acc)[2][2][4][2], const Unit& u, int wr, int wc, int fr, int fq) const {
        const int row0 = u.pm * BM + wr * 64 + fr, col0 = u.pn * BM + wc * 32 + 8 * fq;
#pragma unroll
        for (int ai = 0; ai < 2; ++ai)
#pragma unroll
            for (int mp = 0; mp < 2; ++mp) {
                f32x4 xv[2][2][2];
#pragma unroll
                for (int mm = 0; mm < 2; ++mm)
#pragma unroll
                    for (int bj = 0; bj < 2; ++bj)
#pragma unroll
                        for (int n = 0; n < 2; ++n) xv[mm][bj][n] = *(const f32x4*)(X + (size_t)(row0 + ai * HALF + (mp * 2 + mm) * 16) * 1024 + col0 + bj * HALF + 4 * n);
#pragma unroll
                for (int mm = 0; mm < 2; ++mm)
#pragma unroll
                    for (int bj = 0; bj < 2; ++bj)
#pragma unroll
                        for (int n = 0; n < 2; ++n) *(f32x4*)(O + (size_t)(row0 + ai * HALF + (mp * 2 + mm) * 16) * 1024 + col0 + bj * HALF + 4 * n) = xv[mm][bj][n] + acc[ai][bj][mp * 2 + mm][n];
                asm volatile("" ::: "memory"); }
    }
};

template <class Epi, class Sched, bool ALIGN_EPI = false, bool SP2 = false>
__device__ __forceinline__ void gemm_phase(PG8_LAS unsigned char* lds, const Gemm g, const Sched& S, const Epi& E) {
    const int tid = threadIdx.x, wid = __builtin_amdgcn_readfirstlane(tid >> 6), lane = tid & 63, wr = wid >> 2, wc = wid & 3, fr = lane & 15, fq = lane >> 4;
    const int K = g.K, nt = K / BK;
    unsigned voffA[2], voffB[2];
#pragma unroll
    for (int i = 0; i < 2; ++i) { int R, C; stage_rc(tid * 16 + i * 8192, R, C); const int Rb = Epi::PERM ? ((R & ~31) + perm32(R & 31)) : R;
        voffA[i] = (unsigned)(R * K + C) * 2u; voffB[i] = (unsigned)(Rb * K + C) * 2u; }
    const size_t kstep = (size_t)(BK * 2);
    const size_t hstep = (size_t)HALF * K * 2;
    const size_t tstep = 2 * hstep;
    const unsigned ldsw = (unsigned)wid * 1024u;
    const int aoff = lds_byte(wr * 64 + fr, fq * 8), boff = lds_byte(wc * 32 + fr, fq * 8);
#define PG8_SA(b, h) (((b) * 2 + (h)) * HTB)
#define PG8_SB(b, h) ((4 + (b) * 2 + (h)) * HTB)
#define PG8_STAGE(bufoff, gbase, voff) do { _Pragma("unroll") for (int _i = 0; _i < 2; ++_i) \
        __builtin_amdgcn_global_load_lds((const unsigned*)((const char*)(gbase) + (voff)[_i]), (PG8_LAS unsigned*)(lds + (bufoff) + ldsw + _i * 8192), 16, 0, 0); } while (0)
#define PG8_LDA(dst, b, h) do { _Pragma("unroll") for (int m = 0; m < 4; ++m) _Pragma("unroll") for (int k = 0; k < 2; ++k) dst[m][k] = *(const PG8_LAS bf16x8*)(lds + PG8_SA(b, h) + aoff + m * 2048 + k * 1024); } while (0)
#define PG8_LDB(dst, b, h) do { _Pragma("unroll") for (int n = 0; n < 2; ++n) _Pragma("unroll") for (int k = 0; k < 2; ++k) dst[n][k] = *(const PG8_LAS bf16x8*)(lds + PG8_SB(b, h) + boff + n * 2048 + k * 1024); } while (0)
#define PG8_MMA(ai, bj, At, Bt) do { __builtin_amdgcn_s_setprio(1); _Pragma("unroll") for (int m = 0; m < 4; ++m) _Pragma("unroll") for (int n = 0; n < 2; ++n) _Pragma("unroll") for (int k = 0; k < 2; ++k) \
        acc[ai][bj][m][n] = __builtin_amdgcn_mfma_f32_16x16x32_bf16(Bt[n][k], At[m][k], acc[ai][bj][m][n], 0, 0, 0); __builtin_amdgcn_s_setprio(0); } while (0)
#define PG8_WAIT_V(n) asm volatile("s_waitcnt vmcnt(" #n ")" ::: "memory")
#define PG8_WAIT_L(n) asm volatile("s_waitcnt lgkmcnt(" #n ")" ::: "memory")
#define PG8_BAR __builtin_amdgcn_s_barrier()
#define PG8_SCHED __builtin_amdgcn_sched_barrier(0)
    Unit cur, nxt; int ui = 0;
    if (!S.next(0, cur)) return;
    f32x4 acc[2][2][4][2];
#pragma unroll
    for (int a = 0; a < 2; ++a)
#pragma unroll
        for (int b = 0; b < 2; ++b)
#pragma unroll
            for (int m = 0; m < 4; ++m)
#pragma unroll
                for (int n = 0; n < 2; ++n) acc[a][b][m][n] = (f32x4){0.f, 0.f, 0.f, 0.f};
    bf16x8 At[4][2], B0[2][2], B1[2][2];
    const char* cA = (const char*)g.A + (size_t)cur.pm * tstep; const char* cB = (const char*)g.Bt + (size_t)cur.pn * tstep;
    S.a_ready(cur);
    if constexpr (SP2) {
        PG8_STAGE(PG8_SB(0, 0), cB, voffB); PG8_STAGE(PG8_SB(0, 1), cB + hstep, voffB); PG8_STAGE(PG8_SA(0, 0), cA, voffA); PG8_STAGE(PG8_SA(0, 1), cA + hstep, voffA);
        if (wr == 1) PG8_BAR;
        PG8_WAIT_V(2); PG8_BAR;
        PG8_STAGE(PG8_SB(1, 0), cB + kstep, voffB); PG8_STAGE(PG8_SA(1, 0), cA + kstep, voffA); PG8_STAGE(PG8_SB(1, 1), cB + hstep + kstep, voffB);
        PG8_WAIT_V(6); PG8_BAR;
    } else {
        PG8_STAGE(PG8_SB(0, 0), cB, voffB); PG8_STAGE(PG8_SA(0, 0), cA, voffA); PG8_STAGE(PG8_SB(0, 1), cB + hstep, voffB); PG8_STAGE(PG8_SA(0, 1), cA + hstep, voffA);
        if (wr == 1) PG8_BAR;
        PG8_WAIT_V(4); PG8_BAR;
        PG8_STAGE(PG8_SB(1, 0), cB + kstep, voffB); PG8_STAGE(PG8_SA(1, 0), cA + kstep, voffA); PG8_STAGE(PG8_SB(1, 1), cB + hstep + kstep, voffB);
        PG8_WAIT_V(6); PG8_BAR;
    }
    for (;;) {
        const bool has_next = S.next(ui + 1, nxt);
        const char* nA = has_next ? (const char*)g.A + (size_t)nxt.pm * tstep : cA; const char* nB = has_next ? (const char*)g.Bt + (size_t)nxt.pn * tstep : cB;
        for (int t = 0; t < nt; t += 2) {
            const bool last = (t == nt - 2);
            const char* a1 = cA + (size_t)(t + 1) * kstep;
            const char* a2 = last ? nA : cA + (size_t)(t + 2) * kstep; const char* b2 = last ? nB : cB + (size_t)(t + 2) * kstep;
            const char* a3 = a2 + kstep; const char* b3 = b2 + kstep;
            if (last && has_next) S.a_ready(nxt);
            if constexpr (SP2) {
            PG8_LDB(B0, 0, 0); PG8_LDB(B1, 0, 1); PG8_SCHED; PG8_LDA(At, 0, 0); PG8_STAGE(PG8_SA(1, 1), a1 + hstep, voffA);
            PG8_WAIT_V(8); PG8_WAIT_L(0); PG8_BAR; PG8_MMA(0, 0, At, B0); PG8_MMA(0, 1, At, B1); PG8_BAR; PG8_SCHED;
            PG8_LDA(At, 0, 1); PG8_STAGE(PG8_SB(0, 0), b2, voffB); PG8_STAGE(PG8_SB(0, 1), b2 + hstep, voffB); PG8_STAGE(PG8_SA(0, 0), a2, voffA);
            PG8_WAIT_V(8); PG8_WAIT_L(0); PG8_BAR; PG8_MMA(1, 0, At, B0); PG8_MMA(1, 1, At, B1); PG8_BAR; PG8_SCHED;
            PG8_LDB(B0, 1, 0); PG8_LDB(B1, 1, 1); PG8_SCHED; PG8_LDA(At, 1, 0); PG8_STAGE(PG8_SA(0, 1), a2 + hstep, voffA);
            PG8_WAIT_V(8); PG8_WAIT_L(0); PG8_BAR; PG8_MMA(0, 0, At, B0); PG8_MMA(0, 1, At, B1); PG8_BAR; PG8_SCHED;
            PG8_LDA(At, 1, 1); PG8_STAGE(PG8_SB(1, 0), b3, voffB); PG8_STAGE(PG8_SB(1, 1), b3 + hstep, voffB); PG8_STAGE(PG8_SA(1, 0), a3, voffA);
            PG8_WAIT_V(8); PG8_WAIT_L(0); PG8_BAR; PG8_MMA(1, 0, At, B0); PG8_MMA(1, 1, At, B1); PG8_BAR; PG8_SCHED;
            } else {
            PG8_LDB(B0, 0, 0); PG8_SCHED; PG8_LDA(At, 0, 0); PG8_STAGE(PG8_SA(1, 1), a1 + hstep, voffA);
            PG8_WAIT_L(8); PG8_BAR; PG8_WAIT_L(0); PG8_MMA(0, 0, At, B0); PG8_BAR; PG8_SCHED;
            PG8_LDB(B1, 0, 1); PG8_STAGE(PG8_SB(0, 0), b2, voffB);
            PG8_BAR; PG8_WAIT_L(0); PG8_MMA(0, 1, At, B1); PG8_BAR;
            PG8_LDA(At, 0, 1); PG8_STAGE(PG8_SA(0, 0), a2, voffA);
            PG8_BAR; PG8_WAIT_L(0); PG8_MMA(1, 0, At, B0); PG8_BAR; PG8_SCHED;
            PG8_STAGE(PG8_SB(0, 1), b2 + hstep, voffB);
            PG8_WAIT_V(6); PG8_BAR; PG8_MMA(1, 1, At, B1); PG8_BAR;
            PG8_LDB(B0, 1, 0); PG8_SCHED; PG8_LDA(At, 1, 0); PG8_STAGE(PG8_SA(0, 1), a2 + hstep, voffA);
            PG8_WAIT_L(8); PG8_BAR; PG8_WAIT_L(0); PG8_MMA(0, 0, At, B0); PG8_BAR; PG8_SCHED;
            PG8_LDB(B1, 1, 1); PG8_STAGE(PG8_SB(1, 0), b3, voffB);
            PG8_BAR; PG8_WAIT_L(0); PG8_MMA(0, 1, At, B1); PG8_BAR;
            PG8_LDA(At, 1, 1); PG8_STAGE(PG8_SA(1, 0), a3, voffA);
            PG8_BAR; PG8_WAIT_L(0); PG8_MMA(1, 0, At, B0); PG8_BAR; PG8_SCHED;
            PG8_STAGE(PG8_SB(1, 1), b3 + hstep, voffB);
            PG8_WAIT_V(6); PG8_BAR; PG8_MMA(1, 1, At, B1); PG8_BAR;
            }
        }
        if constexpr (ALIGN_EPI) { if (wr == 0) PG8_BAR; }
        if constexpr (!Epi::AFTER_DRAIN) { E(acc, cur, wr, wc, fr, fq); S.done(cur); }
        if (!has_next) break;
#pragma unroll
        for (int a = 0; a < 2; ++a)
#pragma unroll
            for (int b = 0; b < 2; ++b)
#pragma unroll
                for (int m = 0; m < 4; ++m)
#pragma unroll
                    for (int n = 0; n < 2; ++n) acc[a][b][m][n] = (f32x4){0.f, 0.f, 0.f, 0.f};
        cur = nxt; cA = nA; cB = nB; ++ui;
        if constexpr (ALIGN_EPI) { if (wr == 1) PG8_BAR; }
    }
    PG8_WAIT_V(0);
    if constexpr (!ALIGN_EPI) { if (wr == 0) PG8_BAR; }
    PG8_BAR;
    if constexpr (Epi::AFTER_DRAIN) { E.fused(acc, cur, wr, wc, fr, fq, lds, wid, lane); S.done(cur); }
#undef PG8_SA
#undef PG8_SB
#undef PG8_STAGE
#undef PG8_LDA
#undef PG8_LDB
#undef PG8_MMA
#undef PG8_WAIT_V
#undef PG8_WAIT_L
#undef PG8_BAR
#undef PG8_SCHED
}
}

#ifndef PG8_SP2
#define PG8_SP2 true
#endif
#ifndef PG8_ALIGN
#define PG8_ALIGN true
#endif
#include <hip/hip_bf16.h>
#include <cmath>
namespace attn_body {
using bf16=__hip_bfloat16;
using bf16x8=__attribute__((ext_vector_type(8)))short;
using s16x4=__attribute__((ext_vector_type(4)))short;
using f32x16=__attribute__((ext_vector_type(16)))float;
using u32x4=__attribute__((ext_vector_type(4)))unsigned;
constexpr int BATCH=16,NVH=32,SEQ=4096,D=64,DM=1024,OP=2048;
constexpr int NW=8,QBLK=32,QB=QBLK*NW,KVBLK=64,NQB=SEQ/QB;
constexpr int ATTN_PITCH=DM, ATTN_UNIT_ROWS=QB;
__device__ __forceinline__ int crow(int r,int hi){return (r&3)+8*(r>>2)+4*hi;}
#define SBAR() __builtin_amdgcn_sched_barrier(0)
__device__ __forceinline__ void cmask(f32x16&p0,f32x16&p1,int jb,int qrel,int hi){
  const float NEG=-INFINITY; int kb=64*jb+4*hi;
  #pragma unroll
  for(int r=0;r<16;++r){int kv=kb+(r&3)+8*(r>>2); if(kv>qrel)p0[r]=NEG; if(kv+32>qrel)p1[r]=NEG;}
}

constexpr int NSLOT=3, SLOTB=8192;
constexpr int LDS_K=0, LDS_V=NSLOT*SLOTB, LDS_WS=2*NSLOT*SLOTB, LDS_OST=LDS_WS+NW*64*4, LDS_BYTES=LDS_OST+NW*4096;
constexpr float C2=0.125f*1.4426950408889634f;
__device__ __forceinline__ void glds16(const void*gsrc,unsigned lds_dst){unsigned keep;
  asm volatile("s_mov_b32 %0, m0\n\ts_mov_b32 m0, %2\n\ts_nop 0\n\tglobal_load_lds_dwordx4 %1, off\n\ts_mov_b32 m0, %0":"=&s"(keep):"v"(gsrc),"s"(lds_dst):"memory");}
__device__ __forceinline__ float max3f(float a,float b,float c){float r;asm("v_max3_f32 %0, %1, %2, %3":"=v"(r):"v"(a),"v"(b),"v"(c));return r;}
__device__ __forceinline__ float max2f(float a,float b){float r;asm("v_max_f32_e32 %0, %1, %2":"=v"(r):"v"(a),"v"(b));return r;}
__device__ __forceinline__ float fadd_s(float a,float b){float r;asm("v_add_f32_e32 %0, %1, %2":"=v"(r):"v"(a),"v"(b));return r;}
__device__ __forceinline__ float fsub_s(float a,float b){float r;asm("v_sub_f32_e32 %0, %1, %2":"=v"(r):"v"(a),"v"(b));return r;}
typedef float f32x2_t __attribute__((ext_vector_type(2))); typedef __bf16 bf16x2_t __attribute__((ext_vector_type(2)));
__device__ __forceinline__ unsigned cvtpk_s(float lo,float hi){f32x2_t v={lo,hi};bf16x2_t b=__builtin_convertvector(v,bf16x2_t);return __builtin_bit_cast(unsigned,b);}
#define WAIT_BAR(N) asm volatile("s_waitcnt vmcnt(" #N ") lgkmcnt(0)\n\ts_barrier":::"memory")

__device__ __forceinline__ void qkt(f32x16&p0,f32x16&p1,const char*Kslot,const bf16x8*qr,const f32x16&negm,int r32,int hi){
  const char*kb=Kslot+hi*1024+r32*16;
  #pragma unroll
  for(int d0=0;d0<4;++d0){
    const bf16x8 b0=*reinterpret_cast<const bf16x8*>(kb+d0*2048);
    const bf16x8 b1=*reinterpret_cast<const bf16x8*>(kb+d0*2048+512);
    if(d0==0){p0=__builtin_amdgcn_mfma_f32_32x32x16_bf16(b0,qr[0],negm,0,0,0);p1=__builtin_amdgcn_mfma_f32_32x32x16_bf16(b1,qr[0],negm,0,0,0);}
    else{p0=__builtin_amdgcn_mfma_f32_32x32x16_bf16(b0,qr[d0],p0,0,0,0);p1=__builtin_amdgcn_mfma_f32_32x32x16_bf16(b1,qr[d0],p1,0,0,0);}}
}
typedef __attribute__((address_space(3))) const char* lds_cptr;
typedef short v4i16_t __attribute__((ext_vector_type(4)));
__device__ __forceinline__ void kload8(bf16x8*kf,lds_cptr kp){
  kf[0]=*(const __attribute__((address_space(3))) bf16x8*)(kp);      kf[1]=*(const __attribute__((address_space(3))) bf16x8*)(kp+512);
  kf[2]=*(const __attribute__((address_space(3))) bf16x8*)(kp+2048); kf[3]=*(const __attribute__((address_space(3))) bf16x8*)(kp+2560);
  kf[4]=*(const __attribute__((address_space(3))) bf16x8*)(kp+4096); kf[5]=*(const __attribute__((address_space(3))) bf16x8*)(kp+4608);
  kf[6]=*(const __attribute__((address_space(3))) bf16x8*)(kp+6144); kf[7]=*(const __attribute__((address_space(3))) bf16x8*)(kp+6656);
}
__device__ __forceinline__ void kload2(bf16x8*kf,lds_cptr kp,int j){ kf[2*j]=*(const __attribute__((address_space(3))) bf16x8*)(kp+j*2048); kf[2*j+1]=*(const __attribute__((address_space(3))) bf16x8*)(kp+j*2048+512); }
__device__ __forceinline__ s16x4 vtr(lds_cptr p){ return __builtin_bit_cast(s16x4,__builtin_amdgcn_ds_read_tr16_b64_v4i16((__attribute__((address_space(3))) v4i16_t*)p)); }
__device__ __forceinline__ float rowmax(const f32x16&p0,const f32x16&p1){
  float a=max3f(p0[0],p0[1],p1[0]),b=max3f(p0[2],p0[3],p1[1]);a=max3f(a,p1[2],p1[3]);
  #pragma unroll
  for(int r=4;r<16;r+=4){a=max3f(a,p0[r],p0[r+1]);b=max3f(b,p0[r+2],p0[r+3]);a=max3f(a,p1[r],p1[r+1]);b=max3f(b,p1[r+2],p1[r+3]);}
  const float m=max2f(a,b);
  auto rr=__builtin_amdgcn_permlane32_swap(__float_as_uint(m),__float_as_uint(m),false,false);
  return max2f(__uint_as_float(rr[0]),__uint_as_float(rr[1]));
}
__device__ __forceinline__ void pv(f32x16*o,int vb,bf16x8 pa0,bf16x8 pa1,bf16x8 pa2,bf16x8 pa3){
  #pragma unroll
  for(int d0=0;d0<2;++d0){s16x4 lo[4],hi[4];
    #pragma unroll
    for(int ks=0;ks<4;++ks){
      asm volatile("ds_read_b64_tr_b16 %0,%1 offset:%c2":"=&v"(lo[ks]):"v"(vb),"i"(d0*4096+ks*1024):"memory");
      asm volatile("ds_read_b64_tr_b16 %0,%1 offset:%c2":"=&v"(hi[ks]):"v"(vb),"i"(d0*4096+ks*1024+512):"memory");}
    asm volatile("s_waitcnt lgkmcnt(0)":::"memory");SBAR();
    #define PK(k) (bf16x8){lo[k][0],lo[k][1],lo[k][2],lo[k][3],hi[k][0],hi[k][1],hi[k][2],hi[k][3]}
    o[d0]=__builtin_amdgcn_mfma_f32_32x32x16_bf16(pa0,PK(0),o[d0],0,0,0);
    o[d0]=__builtin_amdgcn_mfma_f32_32x32x16_bf16(pa1,PK(1),o[d0],0,0,0);
    o[d0]=__builtin_amdgcn_mfma_f32_32x32x16_bf16(pa2,PK(2),o[d0],0,0,0);
    o[d0]=__builtin_amdgcn_mfma_f32_32x32x16_bf16(pa3,PK(3),o[d0],0,0,0);
    #undef PK
  }
}

#ifndef ATTN_STORE16
#define ATTN_STORE16(p,v) (*(u32x4*)(p)=(v))
#endif
template<int THRL> __device__ __forceinline__ void attn_unit(int b,int qcol,int vcol,int ocol,int qb,const bf16*Q,const bf16*__restrict__ K,const bf16*__restrict__ V,bf16*O,char*shm){
  const int tid=threadIdx.x,lane=tid&63,r32=lane&31,hi=lane>>5; const int wid=__builtin_amdgcn_readfirstlane(tid>>6);
  const long rowbase=(long)b*SEQ; const int q0=qb*QB;
  const bf16*Qw=Q+(rowbase+q0+wid*QBLK)*DM+qcol;
  const bf16*Kh=K+rowbase*DM+qcol,*Vh=V+rowbase*DM+vcol;
  const unsigned lds0=(unsigned)(uintptr_t)shm;
  float*wsf=(float*)(shm+LDS_WS)+wid*64;
  const bf16*ksrc=Kh+(long)lane*DM+wid*8;
  const bf16*vsrc=Vh+(long)(16*(wid&3)+(lane>>2))*DM+(wid>>2)*32+(lane&3)*8;
  const unsigned kdst=lds0+LDS_K+wid*1024, vdst=lds0+LDS_V+wid*1024;
  #define DMA_K(t,slot) glds16(ksrc+(long)(t)*KVBLK*DM,(unsigned)__builtin_amdgcn_readfirstlane(kdst+(slot)))
  #define DMA_V(t,slot) glds16(vsrc+(long)(t)*KVBLK*DM,(unsigned)__builtin_amdgcn_readfirstlane(vdst+(slot)))
  const int vb0=(int)(lds0+LDS_V)+((lane>>4)&1)*32+(lane&3)*8+(4*hi+((lane&15)>>2))*64;
  const char*Kbase=shm+LDS_K; bf16x8 kf[8];
  const lds_cptr shm3=(lds_cptr)shm; const lds_cptr kp0=shm3+LDS_K+hi*1024+r32*16; const lds_cptr vp0=shm3+LDS_V+((lane>>4)&1)*32+(lane&3)*8+(4*hi+((lane&15)>>2))*64;
  const int NT=(q0+QB)/KVBLK;
  DMA_K(0,0);DMA_V(0,0);DMA_K(1,SLOTB);
  bf16x8 qr[4];
  #pragma unroll
  for(int d0=0;d0<4;++d0)qr[d0]=*reinterpret_cast<const bf16x8*>(&Qw[(long)r32*DM+d0*16+hi*8]);
  float mhat=0.f,l_reg=0.f;f32x16 o[2];o[0]=f32x16{};o[1]=f32x16{};f32x16 negm=f32x16{};asm volatile("":"+v"(negm));
  const int qrel=wid*QBLK+r32;
  #define CMASK(P0,P1,t) do{int jb_=(t)-(NT-4); if(jb_>=0)cmask(P0,P1,jb_,qrel,hi);}while(0)
  bool resc=false;
  #define START(P0,P1) do{ const float rm=rowmax(P0,P1); resc=false; \
    { const float dl=rm; mhat=fadd_s(mhat,dl); \
      _Pragma("unroll") for(int r=0;r<16;++r){P0[r]=fsub_s(P0[r],dl);P1[r]=fsub_s(P1[r],dl);} \
      _Pragma("unroll") for(int r=0;r<16;++r)negm[r]=-mhat; asm volatile("":"+v"(negm)); } \
    _Pragma("unroll") for(int r=0;r<16;++r)P0[r]=__builtin_amdgcn_exp2f(P0[r]); }while(0)
  #define RESC() do{ if(resc){ asm volatile("s_waitcnt lgkmcnt(0)":::"memory"); \
      _Pragma("unroll") for(int d_=0;d_<2;++d_) _Pragma("unroll") for(int r=0;r<16;++r)o[d_][r]*=wsf[crow(r,hi)]; } }while(0)
  f32x16 pA0,pA1,pB0,pB1;
  int sl_prev=0,sl_cur=0,sl_next=SLOTB;
  #define ROT() do{sl_prev=sl_cur;sl_cur=sl_next;sl_next=(sl_next==(NSLOT-1)*SLOTB)?0:sl_next+SLOTB;}while(0)
  DMA_K(2,2*SLOTB);
  WAIT_BAR(3);
  qkt(pA0,pA1,Kbase,qr,negm,r32,hi);asm volatile("s_nop 15\n\ts_nop 7":"+v"(pA0),"+v"(pA1));CMASK(pA0,pA1,0);
  START(pA0,pA1);
  _Pragma("unroll") for(int r=0;r<16;++r)pA1[r]=__builtin_amdgcn_exp2f(pA1[r]);
  WAIT_BAR(0);
  DMA_K(3,0);DMA_V(1,SLOTB);
  ROT();
  kload8(kf,kp0+sl_cur);
  WAIT_BAR(2);
  s16x4 vlo[8],vhi[8]; u32x4 pw0,pw1,pw2,pw3;
  #define PKW(P,B) cvtpk_s(P[B],P[B+1])
  #define PAF(k) __builtin_bit_cast(bf16x8,pw##k)
  #define VFR(i) (bf16x8){vlo[i][0],vlo[i][1],vlo[i][2],vlo[i][3],vhi[i][0],vhi[i][1],vhi[i][2],vhi[i][3]}
  #define PIN(x) asm volatile("":"+v"(x))
  #define MX3(a,b,c) __builtin_fmaxf(__builtin_fmaxf((a),(b)),(c))
  #define GAPA(MF,A0,A1,A2,A3,W0,W1,PW) do{ MF; sacc+=A0; sacc+=A1; sacc+=A2; sacc+=A3; PIN(sacc); W0; W1; PIN(PW); SBAR(); }while(0)
  #define EX(v) __builtin_amdgcn_exp2f(v)
  #define GAPB(MF,X,B) do{ MF; X[B]=EX(X[B]); X[B+1]=EX(X[B+1]); X[B+2]=EX(X[B+2]); X[B+3]=EX(X[B+3]); PIN(X); SBAR(); }while(0)
  #define VRD(i) do{ vlo[i]=vtr(vp_+(((i)>>2)*4096+((i)&3)*1024)); vhi[i]=vtr(vp_+(((i)>>2)*4096+((i)&3)*1024+512)); }while(0)
  #define KRD(G,j) do{ if(G){ kload2(kf,kp0+sl_next,j); SBAR(); } }while(0)
  #define STEP(C0,C1,P0,P1,t,GK,GV,GL) do{ SBAR(); \
    const lds_cptr vp_=vp0+sl_prev; \
    VRD(0); SBAR(); float sacc=(P0[0]+P0[1]); \
    GAPA(C0=__builtin_amdgcn_mfma_f32_32x32x16_bf16(kf[0],qr[0],negm,0,0,0), P0[2],P0[3],P0[4],P0[5],     pw0[0]=PKW(P0,0), pw0[1]=PKW(P0,2), pw0); \
    VRD(4); SBAR(); GAPA(C1=__builtin_amdgcn_mfma_f32_32x32x16_bf16(kf[1],qr[0],negm,0,0,0), P0[6],P0[7],P0[8],P0[9],     pw0[2]=PKW(P0,4), pw0[3]=PKW(P0,6), pw0); \
    VRD(1); SBAR(); GAPA(C0=__builtin_amdgcn_mfma_f32_32x32x16_bf16(kf[2],qr[1],C0,0,0,0),   P0[10],P0[11],P0[12],P0[13], pw1[0]=PKW(P0,8), pw1[1]=PKW(P0,10), pw1); \
    VRD(5); SBAR(); GAPA(C1=__builtin_amdgcn_mfma_f32_32x32x16_bf16(kf[3],qr[1],C1,0,0,0),   P0[14],P0[15],P1[0],P1[1],   pw1[2]=PKW(P0,12),pw1[3]=PKW(P0,14), pw1); \
    VRD(2); SBAR(); GAPA(C0=__builtin_amdgcn_mfma_f32_32x32x16_bf16(kf[4],qr[2],C0,0,0,0),   P1[2],P1[3],P1[4],P1[5],     pw2[0]=PKW(P1,0), pw2[1]=PKW(P1,2), pw2); \
    VRD(6); SBAR(); GAPA(C1=__builtin_amdgcn_mfma_f32_32x32x16_bf16(kf[5],qr[2],C1,0,0,0),   P1[6],P1[7],P1[8],P1[9],     pw2[2]=PKW(P1,4), pw2[3]=PKW(P1,6), pw2); \
    VRD(3); SBAR(); GAPA(C0=__builtin_amdgcn_mfma_f32_32x32x16_bf16(kf[6],qr[3],C0,0,0,0),   P1[10],P1[11],P1[12],P1[13], pw3[0]=PKW(P1,8), pw3[1]=PKW(P1,10), pw3); \
    VRD(7); SBAR(); GAPA(C1=__builtin_amdgcn_mfma_f32_32x32x16_bf16(kf[7],qr[3],C1,0,0,0),   P1[14],P1[15],0.f,0.f,       pw3[2]=PKW(P1,12),pw3[3]=PKW(P1,14), pw3); \
    l_reg+=sacc; \
    if(GK){DMA_K((t)+3,sl_cur);} if(GV){DMA_V((t)+1,sl_next);} \
    CMASK(C0,C1,t); \
    { float a=MX3(C0[0],C0[1],C1[0]),b=MX3(C0[2],C0[3],C1[1]); a=MX3(a,C1[2],C1[3]); \
      _Pragma("unroll") for(int r=4;r<16;r+=4){a=MX3(a,C0[r],C0[r+1]);b=MX3(b,C0[r+2],C0[r+3]);a=MX3(a,C1[r],C1[r+1]);b=MX3(b,C1[r+2],C1[r+3]);} \
      float rm=__builtin_fmaxf(a,b); { auto rr=__builtin_amdgcn_permlane32_swap(__float_as_uint(rm),__float_as_uint(rm),false,false); rm=__builtin_fmaxf(__uint_as_float(rr[0]),__uint_as_float(rr[1])); } \
      resc=false; \
      if(__builtin_expect(__any(rm>(float)THRL),0)){ const float dl=__builtin_fmaxf(rm,0.f); mhat+=dl; \
        _Pragma("unroll") for(int r=0;r<16;++r){C0[r]-=dl;C1[r]-=dl;} \
        _Pragma("unroll") for(int r=0;r<16;++r)negm[r]=-mhat; asm volatile("":"+v"(negm)); \
        const float f=__builtin_amdgcn_exp2f(-dl); l_reg*=f; if(hi==0)wsf[r32]=f; resc=true; } } \
    SBAR(); \
    GAPB(o[0]=__builtin_amdgcn_mfma_f32_32x32x16_bf16(PAF(0),VFR(0),o[0],0,0,0), C0,0); \
    GAPB(o[1]=__builtin_amdgcn_mfma_f32_32x32x16_bf16(PAF(0),VFR(4),o[1],0,0,0), C0,4); \
    KRD(GL,0); GAPB(o[0]=__builtin_amdgcn_mfma_f32_32x32x16_bf16(PAF(1),VFR(1),o[0],0,0,0), C0,8); \
    KRD(GL,1); GAPB(o[1]=__builtin_amdgcn_mfma_f32_32x32x16_bf16(PAF(1),VFR(5),o[1],0,0,0), C0,12); \
    KRD(GL,2); GAPB(o[0]=__builtin_amdgcn_mfma_f32_32x32x16_bf16(PAF(2),VFR(2),o[0],0,0,0), C1,0); \
    KRD(GL,3); GAPB(o[1]=__builtin_amdgcn_mfma_f32_32x32x16_bf16(PAF(2),VFR(6),o[1],0,0,0), C1,4); \
    GAPB(o[0]=__builtin_amdgcn_mfma_f32_32x32x16_bf16(PAF(3),VFR(3),o[0],0,0,0), C1,8); \
    GAPB(o[1]=__builtin_amdgcn_mfma_f32_32x32x16_bf16(PAF(3),VFR(7),o[1],0,0,0), C1,12); \
    }while(0)
  int t=1;
  #undef CMASK
  #define CMASK(P0,P1,t) do{}while(0)
  for(;t+5<NT;t+=2){
    STEP(pB0,pB1,pA0,pA1,t,true,true,true);     WAIT_BAR(2); RESC(); ROT();
    STEP(pA0,pA1,pB0,pB1,t+1,true,true,true);   WAIT_BAR(2); RESC(); ROT();
  }
  #undef CMASK
  #define CMASK(P0,P1,t) do{int jb_=(t)-(NT-4); if(jb_>=0)cmask(P0,P1,jb_,qrel,hi);}while(0)
  #define ENDW(tt) do{ if((tt)+3<NT){WAIT_BAR(2);} else if((tt)+2<NT){WAIT_BAR(1);} else {WAIT_BAR(0);} }while(0)
  for(;t+1<NT;t+=2){
    STEP(pB0,pB1,pA0,pA1,t,(t+3<NT),(t+1<NT),(t+1<NT));       ENDW(t);   RESC(); ROT();
    STEP(pA0,pA1,pB0,pB1,t+1,(t+4<NT),(t+2<NT),(t+2<NT));     ENDW(t+1); RESC(); ROT();
  }
  STEP(pB0,pB1,pA0,pA1,NT-1,false,false,false); RESC();
  { float sacc=pB0[0]+pB0[1]; _Pragma("unroll") for(int r=2;r<16;++r)sacc+=pB0[r]; _Pragma("unroll") for(int r=0;r<16;++r)sacc+=pB1[r]; l_reg+=sacc;
    pw0=(u32x4){PKW(pB0,0),PKW(pB0,2),PKW(pB0,4),PKW(pB0,6)};pw1=(u32x4){PKW(pB0,8),PKW(pB0,10),PKW(pB0,12),PKW(pB0,14)};pw2=(u32x4){PKW(pB1,0),PKW(pB1,2),PKW(pB1,4),PKW(pB1,6)};pw3=(u32x4){PKW(pB1,8),PKW(pB1,10),PKW(pB1,12),PKW(pB1,14)};
    SBAR(); pv(o,vb0+sl_cur,PAF(0),PAF(1),PAF(2),PAF(3)); }
  #undef PKW
  #undef PAF
  #undef VFR
  #undef PIN
  #undef MX3
  #undef GAPA
  #undef GAPB
  #undef EX
  #undef VRD
  #undef KRD
  #undef STEP
  #undef ENDW
  {auto rr=__builtin_amdgcn_permlane32_swap(__float_as_uint(l_reg),__float_as_uint(l_reg),false,false);l_reg=__uint_as_float(rr[0])+__uint_as_float(rr[1]);}
  if(hi==0)wsf[32+r32]=l_reg;asm volatile("s_waitcnt lgkmcnt(0)":::"memory");
  float rli[16];
  #pragma unroll
  for(int r=0;r<16;++r)rli[r]=__builtin_amdgcn_rcpf(wsf[32+crow(r,hi)]);
  bf16*Ow=O+(rowbase+q0+wid*QBLK)*OP+ocol;
  { bf16*stg=(bf16*)(shm+LDS_OST)+wid*2048;
    #pragma unroll
    for(int r=0;r<16;++r){const int orow=crow(r,hi);
      #pragma unroll
      for(int d0=0;d0<2;++d0)stg[orow*64+d0*32+r32]=__float2bfloat16(o[d0][r]*rli[r]);}
    asm volatile("s_waitcnt lgkmcnt(0)":::"memory");
    #pragma unroll
    for(int i=0;i<4;++i){const int row=i*8+(lane>>3),ch=lane&7; const u32x4 v=*(const u32x4*)(stg+row*64+ch*8); ATTN_STORE16(Ow+(long)row*OP+ch*8,v);} }
  asm volatile("s_waitcnt lgkmcnt(0)\n\ts_barrier":::"memory");
  #undef DMA_K
  #undef DMA_V
  #undef CMASK
  #undef START
  #undef RESC
  #undef ROT
}
constexpr int ATTN_LDS_BYTES=LDS_BYTES;
struct AttnTensors { const bf16* Q; const bf16* K; const bf16* V; bf16* O; };
struct AttnUnit { int bh; int qb; };
struct StaticOrder {
  int vcu,G;
  __device__ __forceinline__ explicit StaticOrder(int grid,int v):vcu(v),G(grid){}
  __device__ __forceinline__ bool next(int i,AttnUnit&u)const{ const int p=vcu+(i>>1)*G; if(p>=BATCH*NVH*8)return false; const int s=p&7; u.bh=p>>3; u.qb=(i&1)?15-s:s; return true; }
  __device__ __forceinline__ void a_ready(const AttnUnit&)const{}
  __device__ __forceinline__ void done(const AttnUnit&)const{}
};
template<class Sched,int THRL=8> __device__ __forceinline__ void attn_phase(char*lds,const AttnTensors&T,const Sched&S){
  AttnUnit u;
  for(int i=0;S.next(i,u);++i){ S.a_ready(u); { const int b_=u.bh>>5,vh_=u.bh&31,h_=vh_>>2,c_=(vh_>>1)&1,vf_=vh_&1; attn_unit<THRL>(b_,h_*128+c_*64,h_*128+vf_*64,(h_*2+c_)*128+vf_*64,u.qb,T.Q,T.K,T.V,T.O,lds); } S.done(u); }
}
#undef SBAR
#undef WAIT_BAR
}
namespace cg = cooperative_groups;
constexpr int NWAVES = 8;
#ifndef MK_N_LAUNCHES
#define MK_N_LAUNCHES 1
#endif
constexpr int N_PHASES = 9;
constexpr int N_LAUNCHES = MK_N_LAUNCHES;

constexpr int BATCH = 16, T = 4096, D = 1024, NCOLS = 10240;
constexpr int M = BATCH * T;
constexpr float NORM_EPS = 1e-6f, HEAD_EPS = 1e-5f, LAM_INIT = 0.2f;

constexpr size_t MiB = 1u << 20;
constexpr size_t WS_WIN = 2 * MiB, WS_WA = 22 * MiB, WS_WB = 24 * MiB, WS_WO = 26 * MiB;
constexpr size_t WS_XN = 32 * MiB, WS_SB = 160 * MiB, WS_CX = 288 * MiB, WS_Q = 416 * MiB, WS_K = 544 * MiB, WS_V = 672 * MiB, WS_ZB = 800 * MiB, WS_END = 928 * MiB;
constexpr size_t WS_AA = WS_XN;
constexpr size_t WS_O = WS_XN;
constexpr size_t WS_GAYA = WS_CX;
constexpr size_t WS_AB = WS_ZB;
constexpr size_t WS_MM = WS_K;

constexpr int RING_OFF = 0, RING_BYTES = 131072;
constexpr int LDS_BYTES = 147456;

#define GAS __attribute__((address_space(1)))
#define LAS __attribute__((address_space(3)))
typedef unsigned short bf16;
typedef unsigned v4u __attribute__((ext_vector_type(4)));
typedef float f32x4 __attribute__((ext_vector_type(4)));
#define LDS_WAIT() asm volatile("s_waitcnt lgkmcnt(0)" ::: "memory")
__device__ __forceinline__ unsigned f2bf(float f) { unsigned u = __builtin_bit_cast(unsigned, f); return (u + 0x7fffu + ((u >> 16) & 1u)) >> 16; }
__device__ __forceinline__ unsigned pk2(float lo, float hi) { return f2bf(lo) | (f2bf(hi) << 16); }
__device__ __forceinline__ float blo(unsigned w) { return __builtin_bit_cast(float, w << 16); }
__device__ __forceinline__ float bhi(unsigned w) { return __builtin_bit_cast(float, w & 0xffff0000u); }

struct Frame {
    LAS unsigned char* lds;
    int tid, lane, wave, vcu, G;
};
__device__ __forceinline__ float wave_sum(float v) {
#pragma unroll
    for (int o = 1; o < 64; o <<= 1) v += __shfl_xor(v, o);
    return v;
}
__device__ __forceinline__ int win_dest_row(int n) {
    if (n >= 4096) return n;
    const int q = n >> 10, ch = n & 1023, pn = ch >> 6, c6 = ch & 63, wc = c6 >> 4, fq = (c6 >> 2) & 3, j = c6 & 3;
    return 256 * pn + 128 * (q >> 1) + 32 * wc + 8 * fq + 4 * (q & 1) + j;
}
template <bool PERMCONV>
__device__ __forceinline__ void p0_transpose_item(const float* W, int K, int N, bf16* WT, LAS float* scr, int item, int lane) {
    const int nblk = N / 32, kb = item / nblk, nb = item % nblk, k0 = 64 * kb, n0 = 32 * nb;
#pragma unroll 8
    for (int i = 0; i < 32; ++i) { const int kk = 2 * i + (lane >> 5); scr[kk * 33 + (lane & 31)] = W[(size_t)(k0 + kk) * N + n0 + (lane & 31)]; }
    LDS_WAIT(); asm volatile("" ::: "memory");
    const int c = lane & 7;
#pragma unroll
    for (int j = 0; j < 4; ++j) { const int n = (lane >> 3) + 8 * j; const LAS float* s = scr + (8 * c) * 33 + n;
        v4u o; o.x = pk2(s[0 * 33], s[1 * 33]); o.y = pk2(s[2 * 33], s[3 * 33]); o.z = pk2(s[4 * 33], s[5 * 33]); o.w = pk2(s[6 * 33], s[7 * 33]);
        const int dr = PERMCONV ? win_dest_row(n0 + n) : (n0 + n);
        *(GAS v4u*)(WT + (size_t)dr * K + k0 + 8 * c) = o; }
    LDS_WAIT(); asm volatile("" ::: "memory");
}
template <int NR>
__device__ __forceinline__ void rms_rows_to_bf16(int lane, const float* xrow, size_t rstride, const float* w, bf16* orow) {
    f32x4 v[NR][4]; float s2[NR];
#pragma unroll
    for (int r = 0; r < NR; ++r) { const GAS f32x4* xr = (const GAS f32x4*)(xrow + r * rstride) + lane;
#pragma unroll
        for (int j = 0; j < 4; ++j) v[r][j] = xr[64 * j]; }
    const GAS f32x4* wr = (const GAS f32x4*)w + lane; f32x4 ww[4];
#pragma unroll
    for (int j = 0; j < 4; ++j) ww[j] = wr[64 * j];
#pragma unroll
    for (int r = 0; r < NR; ++r) { s2[r] = 0.f;
#pragma unroll
        for (int j = 0; j < 4; ++j) s2[r] += (v[r][j].x * v[r][j].x + v[r][j].y * v[r][j].y) + (v[r][j].z * v[r][j].z + v[r][j].w * v[r][j].w); }
#pragma unroll
    for (int o = 1; o < 64; o <<= 1)
#pragma unroll
        for (int r = 0; r < NR; ++r) s2[r] += __shfl_xor(s2[r], o);
#pragma unroll
    for (int r = 0; r < NR; ++r) { const float rstd = 1.f / sqrtf(s2[r] * (1.f / D) + NORM_EPS);
        GAS unsigned long long* o8 = (GAS unsigned long long*)(orow + r * rstride) + lane;
#pragma unroll
        for (int j = 0; j < 4; ++j)
            o8[64 * j] = (unsigned long long)pk2(v[r][j].x * rstd * ww[j].x, v[r][j].y * rstd * ww[j].y) | ((unsigned long long)pk2(v[r][j].z * rstd * ww[j].z, v[r][j].w * rstd * ww[j].w) << 32); }
}
template <int NR>
__device__ __forceinline__ void rms_rows_f32(int lane, const float* xrow, size_t rstride, const float* w, float* orow) {
    f32x4 v[NR][4]; float s2[NR];
#pragma unroll
    for (int r = 0; r < NR; ++r) { const GAS f32x4* xr = (const GAS f32x4*)(xrow + r * rstride) + lane;
#pragma unroll
        for (int j = 0; j < 4; ++j) v[r][j] = xr[64 * j]; }
    const GAS f32x4* wr = (const GAS f32x4*)w + lane; f32x4 ww[4];
#pragma unroll
    for (int j = 0; j < 4; ++j) ww[j] = wr[64 * j];
#pragma unroll
    for (int r = 0; r < NR; ++r) { s2[r] = 0.f;
#pragma unroll
        for (int j = 0; j < 4; ++j) s2[r] += (v[r][j].x * v[r][j].x + v[r][j].y * v[r][j].y) + (v[r][j].z * v[r][j].z + v[r][j].w * v[r][j].w); }
#pragma unroll
    for (int o = 1; o < 64; o <<= 1)
#pragma unroll
        for (int r = 0; r < NR; ++r) s2[r] += __shfl_xor(s2[r], o);
#pragma unroll
    for (int r = 0; r < NR; ++r) { const float rstd = 1.f / sqrtf(s2[r] * (1.f / D) + NORM_EPS);
        GAS f32x4* o = (GAS f32x4*)(orow + r * rstride) + lane;
#pragma unroll
        for (int j = 0; j < 4; ++j) o[64 * j] = v[r][j] * rstd * ww[j]; }
}

struct Args { const float* in[14]; float* out; unsigned char* ws; int ph_lo, ph_hi; };
__device__ __forceinline__ int opq(int k) { asm volatile("" : "+s"(k)); return k; }
__device__ __forceinline__ size_t opq64(size_t k) { asm volatile("" : "+s"(k)); return k; }
__global__ void __launch_bounds__(NWAVES * 64, 2) hyb_fwd(Args args) {
    __builtin_assume(__builtin_amdgcn_workitem_id_y() == 0); __builtin_assume(__builtin_amdgcn_workitem_id_z() == 0);
    extern __shared__ __attribute__((aligned(16))) unsigned char lds[];
    Frame F;
    F.lds = (LAS unsigned char*)lds;
    F.tid = threadIdx.x; F.lane = F.tid & 63; F.wave = __builtin_amdgcn_readfirstlane(F.tid >> 6);
    F.G = gridDim.x; { const int bx = blockIdx.x; F.vcu = (F.G % 8 == 0) ? (bx % 8) * (F.G / 8) + bx / 8 : bx; }
#define KIN(k) (args.in[opq(k)])
#define WSP(off) ((bf16*)(args.ws + (size_t)opq64(off)))
    const int lo = args.ph_lo, hi = args.ph_hi;
#define IN(k) (lo <= (k) && (k) < hi)
#define SEAM(k) do { if (IN(k) && IN((k) + 1)) { cg::this_grid().sync(); } } while (0)
    const int gw = F.vcu * NWAVES + F.wave, NGW = F.G * NWAVES;

    if (IN(0)) {
        LAS float* scr = (LAS float*)(F.lds + RING_OFF + F.wave * 16384);
        const float* x = KIN(0); const float* norm_w = KIN(1); const float* w_in = KIN(2); const float* w_out_a = KIN(4); const float* w_out_b = KIN(10); const float* w_o = KIN(12);
        bf16* Win_t = WSP(WS_WIN); bf16* Wa_t = WSP(WS_WA); bf16* Wb_t = WSP(WS_WB); bf16* Wo_t = WSP(WS_WO); bf16* XN = WSP(WS_XN);
        constexpr int I_IN = (D / 64) * (NCOLS / 32), I_SQ = (D / 64) * (D / 32);
        constexpr int NITEMS = I_IN + 3 * I_SQ;
        for (int it = gw; it < NITEMS; it += NGW) {
            int r = it;
            if (r < I_IN) { p0_transpose_item<true>(w_in, D, NCOLS, Win_t, scr, r, F.lane); continue; } r -= I_IN;
            if (r < I_SQ) { p0_transpose_item<false>(w_out_a, D, D, Wa_t, scr, r, F.lane); continue; } r -= I_SQ;
            if (r < I_SQ) { p0_transpose_item<false>(w_out_b, D, D, Wb_t, scr, r, F.lane); continue; } r -= I_SQ;
            p0_transpose_item<false>(w_o, D, D, Wo_t, scr, r, F.lane);
        }
        for (int m = gw; m < M; m += 4 * NGW) rms_rows_to_bf16<4>(F.lane, x + (size_t)m * D, (size_t)NGW * D, norm_w, XN + (size_t)m * D);
    }
    SEAM(0);
    if (IN(1)) {
        bf16* XN = WSP(WS_XN); bf16* Win_t = WSP(WS_WIN); bf16* CX = WSP(WS_CX); bf16* SB = WSP(WS_SB); bf16* QB_ = WSP(WS_Q); bf16* GT = (bf16*)args.out; const float* b_gate = KIN(11);
        pg8::Gemm g{XN, Win_t, M, NCOLS, D}; pg8::StaticOrder S; S.init(M, NCOLS, F.G, (int)blockIdx.x);
        pg8::EpiInProj E{CX, SB, QB_, (size_t)(WS_K - WS_Q) / 2, GT, b_gate, attn_body::C2};
        pg8::gemm_phase<pg8::EpiInProj, pg8::StaticOrder, PG8_ALIGN, PG8_SP2>(F.lds + RING_OFF, g, S, E);
    }
    SEAM(1);
    if (IN(2)) {
        const int cgp = F.tid & 127, rs = F.tid >> 7, ch = cgp * 8;
        const float* conv_w = KIN(3); bf16* CX = WSP(WS_CX); bf16* SB = WSP(WS_SB); bf16* AA = WSP(WS_AA);
        float w0[8], w1[8], w2[8];
#pragma unroll
        for (int e = 0; e < 8; ++e) { w0[e] = conv_w[ch + e]; w1[e] = conv_w[1024 + ch + e]; w2[e] = conv_w[2048 + ch + e]; }
        for (int item = F.vcu; item < M / 64; item += F.G) {
            const int r0 = item * 64 + rs * 16;
            const bool first = (r0 % T) == 0;
            v4u p2 = (v4u){0u, 0u, 0u, 0u}, p1 = (v4u){0u, 0u, 0u, 0u};
            if (!first) { p2 = *(const GAS v4u*)(CX + (size_t)(r0 - 2) * 1024 + ch); p1 = *(const GAS v4u*)(CX + (size_t)(r0 - 1) * 1024 + ch); }
#pragma unroll
            for (int hb = 0; hb < 2; ++hb) {
                v4u c[8], s[8];
#pragma unroll
                for (int i = 0; i < 8; ++i) { c[i] = *(const GAS v4u*)(CX + (size_t)(r0 + hb * 8 + i) * 1024 + ch); s[i] = *(const GAS v4u*)(SB + (size_t)(r0 + hb * 8 + i) * 1024 + ch); }
#pragma unroll
                for (int i = 0; i < 8; ++i) {
                    const v4u cur = c[i]; v4u o;
#pragma unroll
                    for (int q = 0; q < 4; ++q) {
                        const float ylo = w0[2 * q] * blo(p2[q]) + w1[2 * q] * blo(p1[q]) + w2[2 * q] * blo(cur[q]);
                        const float yhi = w0[2 * q + 1] * bhi(p2[q]) + w1[2 * q + 1] * bhi(p1[q]) + w2[2 * q + 1] * bhi(cur[q]);
                        o[q] = pk2(ylo * blo(s[i][q]), yhi * bhi(s[i][q]));
                    }
                    *(GAS v4u*)(AA + (size_t)(r0 + hb * 8 + i) * 1024 + ch) = o;
                    p2 = p1; p1 = cur;
                }
            }
        }
    }
    SEAM(2);
    if (IN(3)) {
        bf16* AA = WSP(WS_AA); bf16* Wa_t = WSP(WS_WA); bf16* GAYA = WSP(WS_GAYA); bf16* GT = (bf16*)args.out;
        pg8::Gemm g{AA, Wa_t, M, D, D}; pg8::StaticOrder S; S.init(M, D, F.G, (int)blockIdx.x);
        pg8::EpiGate<false> E{GAYA, GT, nullptr};
        pg8::gemm_phase<pg8::EpiGate<false>, pg8::StaticOrder, PG8_ALIGN, PG8_SP2>(F.lds + RING_OFF, g, S, E);
    }
    SEAM(3);
    if (IN(4)) {
        bf16* QB_ = WSP(WS_Q); bf16* KB = WSP(WS_K); bf16* VB = WSP(WS_V); bf16* OB = WSP(WS_O);
        const attn_body::AttnTensors AT{(const attn_body::bf16*)QB_, (const attn_body::bf16*)KB, (const attn_body::bf16*)VB, (attn_body::bf16*)OB};
        const attn_body::StaticOrder S((int)F.G, F.vcu);
        attn_body::attn_phase<attn_body::StaticOrder>((char*)lds + RING_OFF, AT, S);
    }
    SEAM(4);
    if (IN(5)) {
        const float* lq1 = KIN(5); const float* lk1 = KIN(6); const float* lq2 = KIN(7); const float* lk2 = KIN(8); const float* head_w = KIN(9);
        bf16* OB = WSP(WS_O); bf16* ZB = WSP(WS_ZB); bf16* AB = WSP(WS_AB);
        const float d1 = lq1[F.lane] * lk1[F.lane], d2 = lq2[F.lane] * lk2[F.lane];
        const float lam = __expf(wave_sum(d1)) - __expf(wave_sum(d2)) + LAM_INIT;
        const int rsub = F.tid >> 7, l = F.tid & 127, h = l >> 4, j0 = (l & 15) * 8;
        float hw[8];
#pragma unroll
        for (int e = 0; e < 8; ++e) hw[e] = head_w[j0 + e] * (1.0f - LAM_INIT);
        for (int item = F.vcu; item < M / 32; item += F.G) {
#pragma unroll 2
            for (int ps = 0; ps < 8; ++ps) {
                const size_t row = (size_t)item * 32 + ps * 4 + rsub;
                const v4u o1 = *(const GAS v4u*)(OB + row * 2048 + (h * 2) * 128 + j0), o2 = *(const GAS v4u*)(OB + row * 2048 + (h * 2 + 1) * 128 + j0);
                const v4u z = *(const GAS v4u*)(ZB + row * 1024 + h * 128 + j0);
                float d[8]; float ss = 0.f;
#pragma unroll
                for (int q = 0; q < 4; ++q) { d[2 * q] = blo(o1[q]) - lam * blo(o2[q]); d[2 * q + 1] = bhi(o1[q]) - lam * bhi(o2[q]); ss += d[2 * q] * d[2 * q] + d[2 * q + 1] * d[2 * q + 1]; }
                ss += __shfl_xor(ss, 1); ss += __shfl_xor(ss, 2); ss += __shfl_xor(ss, 4); ss += __shfl_xor(ss, 8);
                const float rstd = 1.f / sqrtf(ss * (1.f / 128.f) + HEAD_EPS);
                v4u o;
#pragma unroll
                for (int q = 0; q < 4; ++q) o[q] = pk2(d[2 * q] * rstd * hw[2 * q] * pg8::silu_f(blo(z[q])), d[2 * q + 1] * rstd * hw[2 * q + 1] * pg8::silu_f(bhi(z[q])));
                *(GAS v4u*)(AB + row * 1024 + h * 128 + j0) = o;
            }
        }
    }
    SEAM(5);
    if (IN(6)) {
        bf16* AB = WSP(WS_AB); bf16* Wb_t = WSP(WS_WB); bf16* MM = WSP(WS_MM); bf16* GAYA = WSP(WS_GAYA); bf16* GT = (bf16*)args.out;
        pg8::Gemm g{AB, Wb_t, M, D, D}; pg8::StaticOrder S; S.init(M, D, F.G, (int)blockIdx.x);
        pg8::EpiGate<true> E{MM, GT + 1024, GAYA};
        pg8::gemm_phase<pg8::EpiGate<true>, pg8::StaticOrder, PG8_ALIGN, PG8_SP2>(F.lds + RING_OFF, g, S, E);
    }
    SEAM(6);
    if (IN(7)) {
        bf16* MM = WSP(WS_MM); bf16* Wo_t = WSP(WS_WO); float* out = args.out; const float* x = KIN(0);
        pg8::Gemm g{MM, Wo_t, M, D, D}; pg8::StaticOrder S; S.init(M, D, F.G, (int)blockIdx.x);
        pg8::EpiResF32 E{out, x};
        pg8::gemm_phase<pg8::EpiResF32, pg8::StaticOrder, PG8_ALIGN, PG8_SP2>(F.lds + RING_OFF, g, S, E);
    }
    SEAM(7);
    if (IN(8)) {
        float* out = args.out; const float* final_w = KIN(13);
        for (int m = gw; m < M; m += 4 * NGW) rms_rows_f32<4>(F.lane, out + (size_t)m * D, (size_t)NGW * D, final_w, out + (size_t)m * D);
    }
#undef IN
#undef SEAM
}

extern "C" void kernel_launch(void* const* d_in, const int* in_sizes, int n_in, void* d_out, int out_size, void* d_ws, size_t ws_size, hipStream_t stream) {
    static int grid = 0;
    if (grid == 0) {
        if (n_in != 14 || in_sizes[0] != M * D || out_size != M * D || ws_size < WS_END) { fprintf(stderr, "kernel_launch: unexpected shapes: n_in %d in0 %d out %d ws %zu\n", n_in, n_in > 0 ? in_sizes[0] : -1, out_size, ws_size); grid = -1; return; }
        int dev = 0, cus = 0, per_cu = 0;
        if (hipGetDevice(&dev) != hipSuccess || hipDeviceGetAttribute(&cus, hipDeviceAttributeMultiprocessorCount, dev) != hipSuccess) { grid = -1; return; }
        if (hipFuncSetAttribute((const void*)hyb_fwd, hipFuncAttributeMaxDynamicSharedMemorySize, LDS_BYTES) != hipSuccess) { fprintf(stderr, "kernel_launch: hipFuncSetAttribute failed\n"); grid = -1; return; }
        if (hipOccupancyMaxActiveBlocksPerMultiprocessor(&per_cu, (const void*)hyb_fwd, NWAVES * 64, LDS_BYTES) != hipSuccess || per_cu < 1) { fprintf(stderr, "kernel_launch: occupancy query says %d\n", per_cu); per_cu = 1; }
        (void)hipGetLastError();
        grid = cus;
    }
    if (grid < 0) return;
    Args a{};
    for (int i = 0; i < 14; ++i) a.in[i] = (const float*)d_in[i];
    a.out = (float*)d_out; a.ws = (unsigned char*)d_ws;
    if (N_LAUNCHES == 1) {
        a.ph_lo = 0; a.ph_hi = N_PHASES;
        void* kargs[] = {&a};
        const hipError_t e = hipLaunchCooperativeKernel((const void*)hyb_fwd, dim3(grid), dim3(NWAVES * 64), kargs, LDS_BYTES, stream);
        if (e != hipSuccess) fprintf(stderr, "kernel_launch: cooperative launch failed: %s (grid %d)\n", hipGetErrorString(e), grid);
    } else {
        for (int li = 0; li < N_PHASES; ++li) {
            a.ph_lo = li; a.ph_hi = li + 1;
            hipLaunchKernelGGL(hyb_fwd, dim3(grid), dim3(NWAVES * 64), LDS_BYTES, stream, a);
        }
    }
}
```

```cpp
#include <hip/hip_runtime.h>
#include <cstdio>
#include <cstdint>
#include <hip/hip_cooperative_groups.h>
namespace pg8 {
#define PG8_LAS __attribute__((address_space(3)))
typedef unsigned short bf16_t;
typedef short bf16x8 __attribute__((ext_vector_type(8)));
typedef float f32x4 __attribute__((ext_vector_type(4)));
typedef unsigned u32x4 __attribute__((ext_vector_type(4)));
constexpr int BM = 256, BK = 64, HALF = 128, HTB = HALF * BK * 2  , STAGE_BYTES = 8 * HTB, NXCD = 8, WGM = 8;

__host__ __device__ __forceinline__ int lds_byte(int r, int c) { const int st = (r >> 4) * 2 + (c >> 5), rr = r & 15, cc = c & 31, ob = rr * 64 + cc * 2; return st * 1024 + (ob ^ (((ob >> 9) & 1) << 5)); }
__host__ __device__ __forceinline__ void stage_rc(int b, int& R, int& C) { const int st = b / 1024, sb = b % 1024, swz = sb ^ (((sb >> 9) & 1) << 5); R = (st >> 1) * 16 + swz / 64; C = (st & 1) * 32 + (swz % 64) / 2; }
__host__ __device__ __forceinline__ int perm32(int rho) { const int n = rho >> 4, i = rho & 15; return 8 * (i >> 2) + 4 * n + (i & 3); }

struct Unit { int pm, pn; };
struct Gemm { const bf16_t* A; const bf16_t* Bt; int M, N, K; };

struct StaticOrder {
    int nM, nN, nwg, G, c;
    __host__ __device__ void init(int M, int N, int G_, int c_) { nM = M / BM; nN = N / BM; nwg = nM * nN; G = G_; c = c_; }
    __host__ __device__ bool next(int i, Unit& u) const {
        const long L = (long)i * G + c; if (L >= nwg) return false;
        int wgid = (int)L; { const int q = nwg / NXCD, r = nwg % NXCD, xcd = wgid % NXCD, off = wgid / NXCD; wgid = (xcd < r ? xcd * (q + 1) : r * (q + 1) + (xcd - r) * q) + off; }
        const int nig = WGM * nN, gid = wgid / nig, fm = gid * WGM, gsz = (nM - fm) < WGM ? (nM - fm) : WGM;
        u.pm = fm + ((wgid % nig) % gsz); u.pn = (wgid % nig) / gsz; return true;
    }
    __device__ __forceinline__ void a_ready(const Unit&) const {}
    __device__ __forceinline__ void done(const Unit&) const {}
};

typedef float cvt_f32x2_t __attribute__((ext_vector_type(2))); typedef __bf16 cvt_bf16x2_t __attribute__((ext_vector_type(2)));
__device__ __forceinline__ unsigned cvt_pk_bf16(float lo, float hi) { cvt_f32x2_t v = {lo, hi}; cvt_bf16x2_t b = __builtin_convertvector(v, cvt_bf16x2_t); return __builtin_bit_cast(unsigned, b); }
typedef float f32x2 __attribute__((ext_vector_type(2)));
__device__ __forceinline__ float sigmoid_f(float x) { return __builtin_amdgcn_rcpf(1.0f + __builtin_amdgcn_exp2f(-1.4426950408889634f * x)); }
__device__ __forceinline__ float silu_f(float x) { return x * sigmoid_f(x); }
__device__ __forceinline__ float bf_lo(unsigned w) { return __builtin_bit_cast(float, w << 16); }
__device__ __forceinline__ float bf_hi(unsigned w) { return __builtin_bit_cast(float, w & 0xffff0000u); }
typedef unsigned u32x2 __attribute__((ext_vector_type(2)));

struct EpiInProj {
    static constexpr bool PERM = true, AFTER_DRAIN = false;
    bf16_t* CX; bf16_t* SB; bf16_t* QKVZ; size_t stride; bf16_t* GT; const float* bgate; float qscale;
    __device__ __forceinline__ void operator()(const f32x4 (&acc)[2][2][4][2], const Unit& u, int wr, int wc, int fr, int fq) const {
        const int row0 = u.pm * BM + wr * 64 + fr;
        if (u.pn < 16) {
            const int ch = u.pn * 64 + wc * 16 + fq * 4;
#pragma unroll
            for (int ai = 0; ai < 2; ++ai)
#pragma unroll
                for (int m = 0; m < 4; ++m) {
                    const size_t off = (size_t)(row0 + ai * HALF + m * 16) * 1024 + ch;
                    const f32x4 xa = acc[ai][0][m][0], cg = acc[ai][0][m][1], bg = acc[ai][1][m][0], za = acc[ai][1][m][1];
                    const f32x4 cx = xa * cg;
                    f32x4 sb; sb[0] = silu_f(za[0]) * bg[0]; sb[1] = silu_f(za[1]) * bg[1]; sb[2] = silu_f(za[2]) * bg[2]; sb[3] = silu_f(za[3]) * bg[3];
                    u32x2 w0, w1; w0.x = cvt_pk_bf16(cx[0], cx[1]); w0.y = cvt_pk_bf16(cx[2], cx[3]); w1.x = cvt_pk_bf16(sb[0], sb[1]); w1.y = cvt_pk_bf16(sb[2], sb[3]);
                    *(u32x2*)(CX + off) = w0; *(u32x2*)(SB + off) = w1;
                }
        } else if (u.pn < 32) {
            const int t = (u.pn - 16) >> 2; bf16_t* base = QKVZ + (size_t)t * stride; const float sc = (t == 0) ? qscale : 1.0f;
            const int col0 = ((u.pn - 16) & 3) * BM + wc * 32 + 8 * fq;
#pragma unroll
            for (int ai = 0; ai < 2; ++ai)
#pragma unroll
                for (int m = 0; m < 4; ++m) { bf16_t* rowp = base + (size_t)(row0 + ai * HALF + m * 16) * 1024 + col0;
#pragma unroll
                    for (int bj = 0; bj < 2; ++bj) { const f32x4 v0 = acc[ai][bj][m][0] * sc, v1 = acc[ai][bj][m][1] * sc;
                        u32x4 w; w.x = cvt_pk_bf16(v0[0], v0[1]); w.y = cvt_pk_bf16(v0[2], v0[3]); w.z = cvt_pk_bf16(v1[0], v1[1]); w.w = cvt_pk_bf16(v1[2], v1[3]);
                        *(u32x4*)(rowp + bj * HALF) = w; } }
        } else {
            const int col0 = (u.pn - 32) * BM + wc * 32 + 8 * fq;
            f32x4 bv[2][2];
#pragma unroll
            for (int bj = 0; bj < 2; ++bj)
#pragma unroll
                for (int n = 0; n < 2; ++n) bv[bj][n] = *(const f32x4*)(bgate + col0 + bj * HALF + 4 * n);
#pragma unroll
            for (int ai = 0; ai < 2; ++ai)
#pragma unroll
                for (int m = 0; m < 4; ++m) { bf16_t* rowp = GT + (size_t)(row0 + ai * HALF + m * 16) * 2048 + col0;
#pragma unroll
                    for (int bj = 0; bj < 2; ++bj) { const f32x4 a0 = acc[ai][bj][m][0] + bv[bj][0], a1 = acc[ai][bj][m][1] + bv[bj][1];
                        u32x4 w; w.x = cvt_pk_bf16(sigmoid_f(a0[0]), sigmoid_f(a0[1])); w.y = cvt_pk_bf16(sigmoid_f(a0[2]), sigmoid_f(a0[3]));
                        w.z = cvt_pk_bf16(sigmoid_f(a1[0]), sigmoid_f(a1[1])); w.w = cvt_pk_bf16(sigmoid_f(a1[2]), sigmoid_f(a1[3]));
                        *(u32x4*)(rowp + bj * HALF) = w; } }
        }
    }
};
template <bool PREV> struct EpiGate {
    static constexpr bool PERM = true, AFTER_DRAIN = false;
    bf16_t* O; const bf16_t* G; const bf16_t* P;
    __device__ __forceinline__ void operator()(const f32x4 (&acc)[2][2][4][2], const Unit& u, int wr, int wc, int fr, int fq) const {
        const int row0 = u.pm * BM + wr * 64 + fr, col0 = u.pn * BM + wc * 32 + 8 * fq;
#pragma unroll
        for (int ai = 0; ai < 2; ++ai) {
            u32x4 g[4][2], p[4][2];
#pragma unroll
            for (int m = 0; m < 4; ++m)
#pragma unroll
                for (int bj = 0; bj < 2; ++bj) { const size_t row = (size_t)(row0 + ai * HALF + m * 16); const int c = col0 + bj * HALF;
                    g[m][bj] = *(const u32x4*)(G + row * 2048 + c); if (PREV) p[m][bj] = *(const u32x4*)(P + row * 1024 + c); }
#pragma unroll
            for (int m = 0; m < 4; ++m)
#pragma unroll
                for (int bj = 0; bj < 2; ++bj) { const size_t row = (size_t)(row0 + ai * HALF + m * 16); const int c = col0 + bj * HALF;
                    const u32x4 gv = g[m][bj]; const f32x4 a0 = acc[ai][bj][m][0], a1 = acc[ai][bj][m][1];
                    float o[8] = {a0[0] * bf_lo(gv.x), a0[1] * bf_hi(gv.x), a0[2] * bf_lo(gv.y), a0[3] * bf_hi(gv.y), a1[0] * bf_lo(gv.z), a1[1] * bf_hi(gv.z), a1[2] * bf_lo(gv.w), a1[3] * bf_hi(gv.w)};
                    if (PREV) { const u32x4 pv = p[m][bj];
                        o[0] += bf_lo(pv.x); o[1] += bf_hi(pv.x); o[2] += bf_lo(pv.y); o[3] += bf_hi(pv.y); o[4] += bf_lo(pv.z); o[5] += bf_hi(pv.z); o[6] += bf_lo(pv.w); o[7] += bf_hi(pv.w); }
                    u32x4 w; w.x = cvt_pk_bf16(o[0], o[1]); w.y = cvt_pk_bf16(o[2], o[3]); w.z = cvt_pk_bf16(o[4], o[5]); w.w = cvt_pk_bf16(o[6], o[7]);
                    *(u32x4*)(O + row * 1024 + c) = w; }
            asm volatile("" ::: "memory"); }
    }
};
struct EpiResF32 {
    static constexpr bool PERM = true, AFTER_DRAIN = false;
    float* O; const float* X;
    __device__ __forceinline__ void operator()(const f32x4 (&acc)[2][2][4][2], const Unit& u, int wr, int wc, int fr, int fq) const {
        const int row0 = u.pm * BM + wr * 64 + fr, col0 = u.pn * BM + wc * 32 + 8 * fq;
#pragma unroll
        for (int ai = 0; ai < 2; ++ai)
#pragma unroll
            for (int mp = 0; mp < 2; ++mp) {
                f32x4 xv[2][2][2];
#pragma unroll
                for (int mm = 0; mm < 2; ++mm)
#pragma unroll
                    for (int bj = 0; bj < 2; ++bj)
#pragma unroll
                        for (int n = 0; n < 2; ++n) xv[mm][bj][n] = *(const f32x4*)(X + (size_t)(row0 + ai * HALF + (mp * 2 + mm) * 16) * 1024 + col0 + bj * HALF + 4 * n);
#pragma unroll
                for (int mm = 0; mm < 2; ++mm)
#pragma unroll
                    for (int bj = 0; bj < 2; ++bj)
#pragma unroll
                        for (int n = 0; n < 2; ++n) *(f32x4*)(O + (size_t)(row0 + ai * HALF + (mp * 2 + mm) * 16) * 1024 + col0 + bj * HALF + 4 * n) = xv[mm][bj][n] + acc[ai][bj][mp * 2 + mm][n];
                asm volatile("" ::: "memory"); }
    }
};

template <class Epi, class Sched, bool ALIGN_EPI = false, bool SP2 = false>
__device__ __forceinline__ void gemm_phase(PG8_LAS unsigned char* lds, const Gemm g, const Sched& S, const Epi& E) {
    const int tid = threadIdx.x, wid = __builtin_amdgcn_readfirstlane(tid >> 6), lane = tid & 63, wr = wid >> 2, wc = wid & 3, fr = lane & 15, fq = lane >> 4;
    const int K = g.K, nt = K / BK;
    unsigned voffA[2], voffB[2];
#pragma unroll
    for (int i = 0; i < 2; ++i) { int R, C; stage_rc(tid * 16 + i * 8192, R, C); const int Rb = Epi::PERM ? ((R & ~31) + perm32(R & 31)) : R;
        voffA[i] = (unsigned)(R * K + C) * 2u; voffB[i] = (unsigned)(Rb * K + C) * 2u; }
    const size_t kstep = (size_t)(BK * 2);
    const size_t hstep = (size_t)HALF * K * 2;
    const size_t tstep = 2 * hstep;
    const unsigned ldsw = (unsigned)wid * 1024u;
    const int aoff = lds_byte(wr * 64 + fr, fq * 8), boff = lds_byte(wc * 32 + fr, fq * 8);
#define PG8_SA(b, h) (((b) * 2 + (h)) * HTB)
#define PG8_SB(b, h) ((4 + (b) * 2 + (h)) * HTB)
#define PG8_STAGE(bufoff, gbase, voff) do { _Pragma("unroll") for (int _i = 0; _i < 2; ++_i) \
        __builtin_amdgcn_global_load_lds((const unsigned*)((const char*)(gbase) + (voff)[_i]), (PG8_LAS unsigned*)(lds + (bufoff) + ldsw + _i * 8192), 16, 0, 0); } while (0)
#define PG8_LDA(dst, b, h) do { _Pragma("unroll") for (int m = 0; m < 4; ++m) _Pragma("unroll") for (int k = 0; k < 2; ++k) dst[m][k] = *(const PG8_LAS bf16x8*)(lds + PG8_SA(b, h) + aoff + m * 2048 + k * 1024); } while (0)
#define PG8_LDB(dst, b, h) do { _Pragma("unroll") for (int n = 0; n < 2; ++n) _Pragma("unroll") for (int k = 0; k < 2; ++k) dst[n][k] = *(const PG8_LAS bf16x8*)(lds + PG8_SB(b, h) + boff + n * 2048 + k * 1024); } while (0)
#define PG8_MMA(ai, bj, At, Bt) do { __builtin_amdgcn_s_setprio(1); _Pragma("unroll") for (int m = 0; m < 4; ++m) _Pragma("unroll") for (int n = 0; n < 2; ++n) _Pragma("unroll") for (int k = 0; k < 2; ++k) \
        acc[ai][bj][m][n] = __builtin_amdgcn_mfma_f32_16x16x32_bf16(Bt[n][k], At[m][k], acc[ai][bj][m][n], 0, 0, 0); __builtin_amdgcn_s_setprio(0); } while (0)
#define PG8_WAIT_V(n) asm volatile("s_waitcnt vmcnt(" #n ")" ::: "memory")
#define PG8_WAIT_L(n) asm volatile("s_waitcnt lgkmcnt(" #n ")" ::: "memory")
#define PG8_BAR __builtin_amdgcn_s_barrier()
#define PG8_SCHED __builtin_amdgcn_sched_barrier(0)
    Unit cur, nxt; int ui = 0;
    if (!S.next(0, cur)) return;
    f32x4 acc[2][2][4][2];
#pragma unroll
    for (int a = 0; a < 2; ++a)
#pragma unroll
        for (int b = 0; b < 2; ++b)
#pragma unroll
            for (int m = 0; m < 4; ++m)
#pragma unroll
                for (int n = 0; n < 2; ++n) acc[a][b][m][n] = (f32x4){0.f, 0.f, 0.f, 0.f};
    bf16x8 At[4][2], B0[2][2], B1[2][2];
    const char* cA = (const char*)g.A + (size_t)cur.pm * tstep; const char* cB = (const char*)g.Bt + (size_t)cur.pn * tstep;
    S.a_ready(cur);
    if constexpr (SP2) {
        PG8_STAGE(PG8_SB(0, 0), cB, voffB); PG8_STAGE(PG8_SB(0, 1), cB + hstep, voffB); PG8_STAGE(PG8_SA(0, 0), cA, voffA); PG8_STAGE(PG8_SA(0, 1), cA + hstep, voffA);
        if (wr == 1) PG8_BAR;
        PG8_WAIT_V(2); PG8_BAR;
        PG8_STAGE(PG8_SB(1, 0), cB + kstep, voffB); PG8_STAGE(PG8_SA(1, 0), cA + kstep, voffA); PG8_STAGE(PG8_SB(1, 1), cB + hstep + kstep, voffB);
        PG8_WAIT_V(6); PG8_BAR;
    } else {
        PG8_STAGE(PG8_SB(0, 0), cB, voffB); PG8_STAGE(PG8_SA(0, 0), cA, voffA); PG8_STAGE(PG8_SB(0, 1), cB + hstep, voffB); PG8_STAGE(PG8_SA(0, 1), cA + hstep, voffA);
        if (wr == 1) PG8_BAR;
        PG8_WAIT_V(4); PG8_BAR;
        PG8_STAGE(PG8_SB(1, 0), cB + kstep, voffB); PG8_STAGE(PG8_SA(1, 0), cA + kstep, voffA); PG8_STAGE(PG8_SB(1, 1), cB + hstep + kstep, voffB);
        PG8_WAIT_V(6); PG8_BAR;
    }
    for (;;) {
        const bool has_next = S.next(ui + 1, nxt);
        const char* nA = has_next ? (const char*)g.A + (size_t)nxt.pm * tstep : cA; const char* nB = has_next ? (const char*)g.Bt + (size_t)nxt.pn * tstep : cB;
        for (int t = 0; t < nt; t += 2) {
            const bool last = (t == nt - 2);
            const char* a1 = cA + (size_t)(t + 1) * kstep;
            const char* a2 = last ? nA : cA + (size_t)(t + 2) * kstep; const char* b2 = last ? nB : cB + (size_t)(t + 2) * kstep;
            const char* a3 = a2 + kstep; const char* b3 = b2 + kstep;
            if (last && has_next) S.a_ready(nxt);
            if constexpr (SP2) {
            PG8_LDB(B0, 0, 0); PG8_LDB(B1, 0, 1); PG8_SCHED; PG8_LDA(At, 0, 0); PG8_STAGE(PG8_SA(1, 1), a1 + hstep, voffA);
            PG8_WAIT_V(8); PG8_WAIT_L(0); PG8_BAR; PG8_MMA(0, 0, At, B0); PG8_MMA(0, 1, At, B1); PG8_BAR; PG8_SCHED;
            PG8_LDA(At, 0, 1); PG8_STAGE(PG8_SB(0, 0), b2, voffB); PG8_STAGE(PG8_SB(0, 1), b2 + hstep, voffB); PG8_STAGE(PG8_SA(0, 0), a2, voffA);
            PG8_WAIT_V(8); PG8_WAIT_L(0); PG8_BAR; PG8_MMA(1, 0, At, B0); PG8_MMA(1, 1, At, B1); PG8_BAR; PG8_SCHED;
            PG8_LDB(B0, 1, 0); PG8_LDB(B1, 1, 1); PG8_SCHED; PG8_LDA(At, 1, 0); PG8_STAGE(PG8_SA(0, 1), a2 + hstep, voffA);
            PG8_WAIT_V(8); PG8_WAIT_L(0); PG8_BAR; PG8_MMA(0, 0, At, B0); PG8_MMA(0, 1, At, B1); PG8_BAR; PG8_SCHED;
            PG8_LDA(At, 1, 1); PG8_STAGE(PG8_SB(1, 0), b3, voffB); PG8_STAGE(PG8_SB(1, 1), b3 + hstep, voffB); PG8_STAGE(PG8_SA(1, 0), a3, voffA);
            PG8_WAIT_V(8); PG8_WAIT_L(0); PG8_BAR; PG8_MMA(1, 0, At, B0); PG8_MMA(1, 1, At, B1); PG8_BAR; PG8_SCHED;
            } else {
            PG8_LDB(B0, 0, 0); PG8_SCHED; PG8_LDA(At, 0, 0); PG8_STAGE(PG8_SA(1, 1), a1 + hstep, voffA);
            PG8_WAIT_L(8); PG8_BAR; PG8_WAIT_L(0); PG8_MMA(0, 0, At, B0); PG8_BAR; PG8_SCHED;
            PG8_LDB(B1, 0, 1); PG8_STAGE(PG8_SB(0, 0), b2, voffB);
            PG8_BAR; PG8_WAIT_L(0); PG8_MMA(0, 1, At, B1); PG8_BAR;
            PG8_LDA(At, 0, 1); PG8_STAGE(PG8_SA(0, 0), a2, voffA);
            PG8_BAR; PG8_WAIT_L(0); PG8_MMA(1, 0, At, B0); PG8_BAR; PG8_SCHED;
            PG8_STAGE(PG8_SB(0, 1), b2 + hstep, voffB);
            PG8_WAIT_V(6); PG8_BAR; PG8_MMA(1, 1, At, B1); PG8_BAR;
            PG8_LDB(B0, 1, 0); PG8_SCHED; PG8_LDA(At, 1, 0); PG8_STAGE(PG8_SA(0, 1), a2 + hstep, voffA);
            PG8_WAIT_L(8); PG8_BAR; PG8_WAIT_L(0); PG8_MMA(0, 0, At, B0); PG8_BAR; PG8_SCHED;
            PG8_LDB(B1, 1, 1); PG8_STAGE(PG8_SB(1, 0), b3, voffB);
            PG8_BAR; PG8_WAIT_L(0); PG8_MMA(0, 1, At, B1); PG8_BAR;
            PG8_LDA(At, 1, 1); PG8_STAGE(PG8_SA(1, 0), a3, voffA);
            PG8_BAR; PG8_WAIT_L(0); PG8_MMA(1, 0, At, B0); PG8_BAR; PG8_SCHED;
            PG8_STAGE(PG8_SB(1, 1), b3 + hstep, voffB);
            PG8_WAIT_V(6); PG8_BAR; PG8_MMA(1, 1, At, B1); PG8_BAR;
            }
        }
        if constexpr (ALIGN_EPI) { if (wr == 0) PG8_BAR; }
        if constexpr (!Epi::AFTER_DRAIN) { E(acc, cur, wr, wc, fr, fq); S.done(cur); }
        if (!has_next) break;
#pragma unroll
        for (int a = 0; a < 2; ++a)
#pragma unroll
            for (int b = 0; b < 2; ++b)
#pragma unroll
                for (int m = 0; m < 4; ++m)
#pragma unroll
                    for (int n = 0; n < 2; ++n) acc[a][b][m][n] = (f32x4){0.f, 0.f, 0.f, 0.f};
        cur = nxt; cA = nA; cB = nB; ++ui;
        if constexpr (ALIGN_EPI) { if (wr == 1) PG8_BAR; }
    }
    PG8_WAIT_V(0);
    if constexpr (!ALIGN_EPI) { if (wr == 0) PG8_BAR; }
    PG8_BAR;
    if constexpr (Epi::AFTER_DRAIN) { E.fused(acc, cur, wr, wc, fr, fq, lds, wid, lane); S.done(cur); }
#undef PG8_SA
#undef PG8_SB
#undef PG8_STAGE
#undef PG8_LDA
#undef PG8_LDB
#undef PG8_MMA
#undef PG8_WAIT_V
#undef PG8_WAIT_L
#undef PG8_BAR
#undef PG8_SCHED
}
}

#ifndef PG8_SP2
#define PG8_SP2 true
#endif
#ifndef PG8_ALIGN
#define PG8_ALIGN true
#endif
#include <hip/hip_bf16.h>
#include <cmath>
namespace attn_body {
using bf16=__hip_bfloat16;
using bf16x8=__attribute__((ext_vector_type(8)))short;
using s16x4=__attribute__((ext_vector_type(4)))short;
using f32x16=__attribute__((ext_vector_type(16)))float;
using u32x4=__attribute__((ext_vector_type(4)))unsigned;
constexpr int BATCH=16,NVH=16,SEQ=4096,D=64,DM=1024,OP=2048;
constexpr int NW=8,QBLK=32,QB=QBLK*NW,KVBLK=64,NQB=SEQ/QB;
constexpr int ATTN_PITCH=DM, ATTN_UNIT_ROWS=QB;
__device__ __forceinline__ int crow(int r,int hi){return (r&3)+8*(r>>2)+4*hi;}
#define SBAR() __builtin_amdgcn_sched_barrier(0)
__device__ __forceinline__ void cmask(f32x16&p0,f32x16&p1,int jb,int qrel,int hi){
  const float NEG=-INFINITY; int kb=64*jb+4*hi;
  #pragma unroll
  for(int r=0;r<16;++r){int kv=kb+(r&3)+8*(r>>2); if(kv>qrel)p0[r]=NEG; if(kv+32>qrel)p1[r]=NEG;}
}

constexpr int NSLOT=3, SLOTB=8192, SLOTV=16384;
constexpr int LDS_K=0, LDS_V=NSLOT*SLOTB, LDS_WS=LDS_V+NSLOT*SLOTV, LDS_OST=LDS_WS+NW*64*4, LDS_BYTES=LDS_OST+NW*4096;
constexpr float C2=0.125f*1.4426950408889634f;
__device__ __forceinline__ void glds16(const void*gsrc,unsigned lds_dst){unsigned keep;
  asm volatile("s_mov_b32 %0, m0\n\ts_mov_b32 m0, %2\n\ts_nop 0\n\tglobal_load_lds_dwordx4 %1, off\n\ts_mov_b32 m0, %0":"=&s"(keep):"v"(gsrc),"s"(lds_dst):"memory");}
__device__ __forceinline__ float max3f(float a,float b,float c){float r;asm("v_max3_f32 %0, %1, %2, %3":"=v"(r):"v"(a),"v"(b),"v"(c));return r;}
__device__ __forceinline__ float max2f(float a,float b){float r;asm("v_max_f32_e32 %0, %1, %2":"=v"(r):"v"(a),"v"(b));return r;}
__device__ __forceinline__ float fadd_s(float a,float b){float r;asm("v_add_f32_e32 %0, %1, %2":"=v"(r):"v"(a),"v"(b));return r;}
__device__ __forceinline__ float fsub_s(float a,float b){float r;asm("v_sub_f32_e32 %0, %1, %2":"=v"(r):"v"(a),"v"(b));return r;}
typedef float f32x2_t __attribute__((ext_vector_type(2))); typedef __bf16 bf16x2_t __attribute__((ext_vector_type(2)));
__device__ __forceinline__ unsigned cvtpk_s(float lo,float hi){f32x2_t v={lo,hi};bf16x2_t b=__builtin_convertvector(v,bf16x2_t);return __builtin_bit_cast(unsigned,b);}
#define WAIT_BAR(N) asm volatile("s_waitcnt vmcnt(" #N ") lgkmcnt(0)\n\ts_barrier":::"memory")

__device__ __forceinline__ void qkt(f32x16&p0,f32x16&p1,const char*Kslot,const bf16x8*qr,const f32x16&negm,int r32,int hi){
  const char*kb=Kslot+hi*1024+r32*16;
  #pragma unroll
  for(int d0=0;d0<4;++d0){
    const bf16x8 b0=*reinterpret_cast<const bf16x8*>(kb+d0*2048);
    const bf16x8 b1=*reinterpret_cast<const bf16x8*>(kb+d0*2048+512);
    if(d0==0){p0=__builtin_amdgcn_mfma_f32_32x32x16_bf16(b0,qr[0],negm,0,0,0);p1=__builtin_amdgcn_mfma_f32_32x32x16_bf16(b1,qr[0],negm,0,0,0);}
    else{p0=__builtin_amdgcn_mfma_f32_32x32x16_bf16(b0,qr[d0],p0,0,0,0);p1=__builtin_amdgcn_mfma_f32_32x32x16_bf16(b1,qr[d0],p1,0,0,0);}}
}
typedef __attribute__((address_space(3))) const char* lds_cptr;
typedef short v4i16_t __attribute__((ext_vector_type(4)));
__device__ __forceinline__ void kload8(bf16x8*kf,lds_cptr kp){
  kf[0]=*(const __attribute__((address_space(3))) bf16x8*)(kp);      kf[1]=*(const __attribute__((address_space(3))) bf16x8*)(kp+512);
  kf[2]=*(const __attribute__((address_space(3))) bf16x8*)(kp+2048); kf[3]=*(const __attribute__((address_space(3))) bf16x8*)(kp+2560);
  kf[4]=*(const __attribute__((address_space(3))) bf16x8*)(kp+4096); kf[5]=*(const __attribute__((address_space(3))) bf16x8*)(kp+4608);
  kf[6]=*(const __attribute__((address_space(3))) bf16x8*)(kp+6144); kf[7]=*(const __attribute__((address_space(3))) bf16x8*)(kp+6656);
}
__device__ __forceinline__ void kload2(bf16x8*kf,lds_cptr kp,int j){ kf[2*j]=*(const __attribute__((address_space(3))) bf16x8*)(kp+j*2048); kf[2*j+1]=*(const __attribute__((address_space(3))) bf16x8*)(kp+j*2048+512); }
__device__ __forceinline__ s16x4 vtr(lds_cptr p){ return __builtin_bit_cast(s16x4,__builtin_amdgcn_ds_read_tr16_b64_v4i16((__attribute__((address_space(3))) v4i16_t*)p)); }
__device__ __forceinline__ float rowmax(const f32x16&p0,const f32x16&p1){
  float a=max3f(p0[0],p0[1],p1[0]),b=max3f(p0[2],p0[3],p1[1]);a=max3f(a,p1[2],p1[3]);
  #pragma unroll
  for(int r=4;r<16;r+=4){a=max3f(a,p0[r],p0[r+1]);b=max3f(b,p0[r+2],p0[r+3]);a=max3f(a,p1[r],p1[r+1]);b=max3f(b,p1[r+2],p1[r+3]);}
  const float m=max2f(a,b);
  auto rr=__builtin_amdgcn_permlane32_swap(__float_as_uint(m),__float_as_uint(m),false,false);
  return max2f(__uint_as_float(rr[0]),__uint_as_float(rr[1]));
}
__device__ __forceinline__ void pv(f32x16*o,int vb,bf16x8 pa0,bf16x8 pa1,bf16x8 pa2,bf16x8 pa3){
  #pragma unroll
  for(int d0=0;d0<4;++d0){s16x4 lo[4],hi[4];
    #pragma unroll
    for(int ks=0;ks<4;++ks){
      asm volatile("ds_read_b64_tr_b16 %0,%1 offset:%c2":"=&v"(lo[ks]):"v"(vb),"i"(d0*4096+ks*1024):"memory");
      asm volatile("ds_read_b64_tr_b16 %0,%1 offset:%c2":"=&v"(hi[ks]):"v"(vb),"i"(d0*4096+ks*1024+512):"memory");}
    asm volatile("s_waitcnt lgkmcnt(0)":::"memory");SBAR();
    #define PK(k) (bf16x8){lo[k][0],lo[k][1],lo[k][2],lo[k][3],hi[k][0],hi[k][1],hi[k][2],hi[k][3]}
    o[d0]=__builtin_amdgcn_mfma_f32_32x32x16_bf16(pa0,PK(0),o[d0],0,0,0);
    o[d0]=__builtin_amdgcn_mfma_f32_32x32x16_bf16(pa1,PK(1),o[d0],0,0,0);
    o[d0]=__builtin_amdgcn_mfma_f32_32x32x16_bf16(pa2,PK(2),o[d0],0,0,0);
    o[d0]=__builtin_amdgcn_mfma_f32_32x32x16_bf16(pa3,PK(3),o[d0],0,0,0);
    #undef PK
  }
}

#ifndef ATTN_STORE16
#define ATTN_STORE16(p,v) (*(u32x4*)(p)=(v))
#endif
template<int THRL> __device__ __forceinline__ void attn_unit(int b,int qcol,int vcol,int ocol,int qb,const bf16*Q,const bf16*__restrict__ K,const bf16*__restrict__ V,bf16*O,char*shm){
  const int tid=threadIdx.x,lane=tid&63,r32=lane&31,hi=lane>>5; const int wid=__builtin_amdgcn_readfirstlane(tid>>6);
  const long rowbase=(long)b*SEQ; const int q0=qb*QB;
  const bf16*Qw=Q+(rowbase+q0+wid*QBLK)*DM+qcol;
  const bf16*Kh=K+rowbase*DM+qcol,*Vh=V+rowbase*DM+vcol;
  const unsigned lds0=(unsigned)(uintptr_t)shm;
  float*wsf=(float*)(shm+LDS_WS)+wid*64;
  const bf16*ksrc=Kh+(long)lane*DM+wid*8;
  const bf16*vsrc=Vh+(long)(16*(wid&3)+(lane>>2))*DM+(wid>>2)*32+(lane&3)*8;
  const unsigned kdst=lds0+LDS_K+wid*1024, vdst=lds0+LDS_V+wid*1024;
  #define DMA_K(t,slot) glds16(ksrc+(long)(t)*KVBLK*DM,(unsigned)__builtin_amdgcn_readfirstlane(kdst+(slot)))
  #define DMA_V(t,slot) do{ glds16(vsrc+(long)(t)*KVBLK*DM,(unsigned)__builtin_amdgcn_readfirstlane(vdst+2*(slot))); glds16(vsrc+(long)(t)*KVBLK*DM+64,(unsigned)__builtin_amdgcn_readfirstlane(vdst+2*(slot)+8192)); }while(0)
  const int vb0=(int)(lds0+LDS_V)+((lane>>4)&1)*32+(lane&3)*8+(4*hi+((lane&15)>>2))*64;
  const char*Kbase=shm+LDS_K; bf16x8 kf[8];
  const lds_cptr shm3=(lds_cptr)shm; const lds_cptr kp0=shm3+LDS_K+hi*1024+r32*16; const lds_cptr vp0=shm3+LDS_V+((lane>>4)&1)*32+(lane&3)*8+(4*hi+((lane&15)>>2))*64;
  const int NT=(q0+QB)/KVBLK;
  DMA_K(0,0);DMA_V(0,0);DMA_K(1,SLOTB);
  bf16x8 qr[4];
  { int lq=lane; asm volatile("":"+v"(lq)); const int r32q=lq&31,hiq=lq>>5;
  _Pragma("unroll") for(int d0=0;d0<4;++d0)qr[d0]=*reinterpret_cast<const bf16x8*>(&Qw[(long)r32q*DM+d0*16+hiq*8]); }
  float mhat=0.f,l_reg=0.f;f32x16 o[4],negm;
  { float z=0.f; asm volatile("":"+v"(z));
    _Pragma("unroll") for(int r=0;r<16;++r){o[0][r]=z;o[1][r]=z;o[2][r]=z;o[3][r]=z;negm[r]=z;} }
  asm volatile("":"+v"(negm));
  const int qrel=wid*QBLK+r32;
  #define CMASK(P0,P1,t) do{int jb_=(t)-(NT-4); if(jb_>=0)cmask(P0,P1,jb_,qrel,hi);}while(0)
  bool resc=false;
  #define START(P0,P1) do{ const float rm=rowmax(P0,P1); resc=false; \
    { const float dl=rm; mhat=fadd_s(mhat,dl); \
      _Pragma("unroll") for(int r=0;r<16;++r){P0[r]=fsub_s(P0[r],dl);P1[r]=fsub_s(P1[r],dl);} \
      _Pragma("unroll") for(int r=0;r<16;++r)negm[r]=-mhat; asm volatile("":"+v"(negm)); } \
    _Pragma("unroll") for(int r=0;r<16;++r)P0[r]=__builtin_amdgcn_exp2f(P0[r]); }while(0)
  #define RESC() do{ if(resc){ asm volatile("s_waitcnt lgkmcnt(0)":::"memory"); \
      _Pragma("unroll") for(int d_=0;d_<4;++d_) _Pragma("unroll") for(int r=0;r<16;++r)o[d_][r]*=wsf[crow(r,hi)]; } }while(0)
  f32x16 c0,c1;
  int sl_prev=0,sl_cur=0,sl_next=SLOTB;
  #define ROT() do{sl_prev=sl_cur;sl_cur=sl_next;sl_next=(sl_next==(NSLOT-1)*SLOTB)?0:sl_next+SLOTB;}while(0)
  DMA_K(2,2*SLOTB);
  WAIT_BAR(4);
  s16x4 vlo[8],vhi[8]; u32x4 pw0,pw1,pw2,pw3;
  #define PKW(P,B) cvtpk_s(P[B],P[B+1])
  #define PAF(k) __builtin_bit_cast(bf16x8,pw##k)
  #define VFR(i) (bf16x8){vlo[i][0],vlo[i][1],vlo[i][2],vlo[i][3],vhi[i][0],vhi[i][1],vhi[i][2],vhi[i][3]}
  #define PIN(x) asm volatile("":"+v"(x))
  qkt(c0,c1,Kbase,qr,negm,r32,hi);asm volatile("s_nop 15\n\ts_nop 7":"+v"(c0),"+v"(c1));CMASK(c0,c1,0);
  START(c0,c1);
  _Pragma("unroll") for(int r=0;r<16;++r)c1[r]=__builtin_amdgcn_exp2f(c1[r]);
  { float sacc=c0[0]+c0[1]; _Pragma("unroll") for(int r=2;r<16;++r)sacc+=c0[r]; _Pragma("unroll") for(int r=0;r<16;++r)sacc+=c1[r]; l_reg+=sacc;
    pw0=(u32x4){PKW(c0,0),PKW(c0,2),PKW(c0,4),PKW(c0,6)};pw1=(u32x4){PKW(c0,8),PKW(c0,10),PKW(c0,12),PKW(c0,14)};pw2=(u32x4){PKW(c1,0),PKW(c1,2),PKW(c1,4),PKW(c1,6)};pw3=(u32x4){PKW(c1,8),PKW(c1,10),PKW(c1,12),PKW(c1,14)}; }
  WAIT_BAR(0);
  DMA_K(3,0);DMA_V(1,SLOTB);
  ROT();
  kload8(kf,kp0+sl_cur);
  WAIT_BAR(3);
  #define MX3(a,b,c) __builtin_fmaxf(__builtin_fmaxf((a),(b)),(c))
  #define EX(v) __builtin_amdgcn_exp2f(v)
  #define GAPB(MF,X,B) do{ MF; X[B]=EX(X[B]); X[B+1]=EX(X[B+1]); X[B+2]=EX(X[B+2]); X[B+3]=EX(X[B+3]); PIN(X); SBAR(); }while(0)
  #define GAPC(MF,A0,A1,A2,A3) do{ MF; sacc+=A0; sacc+=A1; sacc+=A2; sacc+=A3; PIN(sacc); SBAR(); }while(0)
  #define VRD(i) do{ vlo[i]=vtr(vp_+(((i)>>2)*4096+((i)&3)*1024)); vhi[i]=vtr(vp_+(((i)>>2)*4096+((i)&3)*1024+512)); }while(0)
  #define VRD2(i) do{ vlo[i]=vtr(vp_+(8192+((i)>>2)*4096+((i)&3)*1024)); vhi[i]=vtr(vp_+(8192+((i)>>2)*4096+((i)&3)*1024+512)); SBAR(); }while(0)
  #define KRD(G,j) do{ if(G){ kload2(kf,kp0+sl_next,j); SBAR(); } }while(0)
  #define MF32(a,b,c) __builtin_amdgcn_mfma_f32_32x32x16_bf16(a,b,c,0,0,0)
  #define STEP(C0,C1,t,GK,GV,GL) do{ SBAR(); \
    const lds_cptr vp_=vp0+2*sl_prev; \
    VRD(0); SBAR(); C0=MF32(kf[0],qr[0],negm); SBAR(); \
    VRD(4); SBAR(); C1=MF32(kf[1],qr[0],negm); SBAR(); \
    VRD(1); SBAR(); C0=MF32(kf[2],qr[1],C0); SBAR(); \
    VRD(5); SBAR(); C1=MF32(kf[3],qr[1],C1); SBAR(); \
    VRD(2); SBAR(); C0=MF32(kf[4],qr[2],C0); SBAR(); \
    VRD(6); SBAR(); C1=MF32(kf[5],qr[2],C1); SBAR(); \
    VRD(3); SBAR(); C0=MF32(kf[6],qr[3],C0); SBAR(); \
    VRD(7); SBAR(); C1=MF32(kf[7],qr[3],C1); SBAR(); \
    if(GK){DMA_K((t)+3,sl_cur);} if(GV){DMA_V((t)+1,sl_next);} \
    CMASK(C0,C1,t); \
    { float a=MX3(C0[0],C0[1],C1[0]),b=MX3(C0[2],C0[3],C1[1]); a=MX3(a,C1[2],C1[3]); \
      _Pragma("unroll") for(int r=4;r<16;r+=4){a=MX3(a,C0[r],C0[r+1]);b=MX3(b,C0[r+2],C0[r+3]);a=MX3(a,C1[r],C1[r+1]);b=MX3(b,C1[r+2],C1[r+3]);} \
      float rm=__builtin_fmaxf(a,b); { auto rr=__builtin_amdgcn_permlane32_swap(__float_as_uint(rm),__float_as_uint(rm),false,false); rm=__builtin_fmaxf(__uint_as_float(rr[0]),__uint_as_float(rr[1])); } \
      resc=false; \
      if(__builtin_expect(__any(rm>(float)THRL),0)){ const float dl=__builtin_fmaxf(rm,0.f); mhat+=dl; \
        _Pragma("unroll") for(int r=0;r<16;++r){C0[r]-=dl;C1[r]-=dl;} \
        _Pragma("unroll") for(int r=0;r<16;++r)negm[r]=-mhat; asm volatile("":"+v"(negm)); \
        const float f=__builtin_amdgcn_exp2f(-dl); l_reg*=f; if(hi==0)wsf[r32]=f; resc=true; } } \
    SBAR(); \
    GAPB(o[0]=MF32(PAF(0),VFR(0),o[0]), C0,0);  VRD2(0); \
    GAPB(o[1]=MF32(PAF(0),VFR(4),o[1]), C0,4);  VRD2(4); \
    KRD(GL,0); GAPB(o[0]=MF32(PAF(1),VFR(1),o[0]), C0,8);  VRD2(1); \
    KRD(GL,1); GAPB(o[1]=MF32(PAF(1),VFR(5),o[1]), C0,12); VRD2(5); \
    KRD(GL,2); GAPB(o[0]=MF32(PAF(2),VFR(2),o[0]), C1,0);  VRD2(2); \
    KRD(GL,3); GAPB(o[1]=MF32(PAF(2),VFR(6),o[1]), C1,4);  VRD2(6); \
    GAPB(o[0]=MF32(PAF(3),VFR(3),o[0]), C1,8);  VRD2(3); \
    GAPB(o[1]=MF32(PAF(3),VFR(7),o[1]), C1,12); VRD2(7); \
    float sacc=0.f; \
    GAPC(o[2]=MF32(PAF(0),VFR(0),o[2]), C0[0],C0[1],C0[2],C0[3]); \
    GAPC(o[3]=MF32(PAF(0),VFR(4),o[3]), C0[4],C0[5],C0[6],C0[7]);     pw0=(u32x4){PKW(C0,0),PKW(C0,2),PKW(C0,4),PKW(C0,6)}; PIN(pw0); SBAR(); \
    GAPC(o[2]=MF32(PAF(1),VFR(1),o[2]), C0[8],C0[9],C0[10],C0[11]); \
    GAPC(o[3]=MF32(PAF(1),VFR(5),o[3]), C0[12],C0[13],C0[14],C0[15]); pw1=(u32x4){PKW(C0,8),PKW(C0,10),PKW(C0,12),PKW(C0,14)}; PIN(pw1); SBAR(); \
    GAPC(o[2]=MF32(PAF(2),VFR(2),o[2]), C1[0],C1[1],C1[2],C1[3]); \
    GAPC(o[3]=MF32(PAF(2),VFR(6),o[3]), C1[4],C1[5],C1[6],C1[7]);     pw2=(u32x4){PKW(C1,0),PKW(C1,2),PKW(C1,4),PKW(C1,6)}; PIN(pw2); SBAR(); \
    GAPC(o[2]=MF32(PAF(3),VFR(3),o[2]), C1[8],C1[9],C1[10],C1[11]); \
    GAPC(o[3]=MF32(PAF(3),VFR(7),o[3]), C1[12],C1[13],C1[14],C1[15]); pw3=(u32x4){PKW(C1,8),PKW(C1,10),PKW(C1,12),PKW(C1,14)}; PIN(pw3); SBAR(); \
    l_reg+=sacc; \
    }while(0)
  int t=1;
  #undef CMASK
  #define CMASK(P0,P1,t) do{}while(0)
  for(;t+5<NT;t+=2){
    STEP(c0,c1,t,true,true,true);     WAIT_BAR(3); RESC(); ROT();
    STEP(c0,c1,t+1,true,true,true);   WAIT_BAR(3); RESC(); ROT();
  }
  #undef CMASK
  #define CMASK(P0,P1,t) do{int jb_=(t)-(NT-4); if(jb_>=0)cmask(P0,P1,jb_,qrel,hi);}while(0)
  #define ENDW(tt) do{ if((tt)+3<NT){WAIT_BAR(3);} else if((tt)+2<NT){WAIT_BAR(2);} else {WAIT_BAR(0);} }while(0)
  for(;t+1<NT;t+=2){
    STEP(c0,c1,t,(t+3<NT),(t+1<NT),(t+1<NT));       ENDW(t);   RESC(); ROT();
    STEP(c0,c1,t+1,(t+4<NT),(t+2<NT),(t+2<NT));     ENDW(t+1); RESC(); ROT();
  }
  STEP(c0,c1,NT-1,false,false,false); RESC();
  SBAR(); pv(o,vb0+2*sl_cur,PAF(0),PAF(1),PAF(2),PAF(3));
  #undef PKW
  #undef PAF
  #undef VFR
  #undef PIN
  #undef MX3
  #undef GAPB
  #undef GAPC
  #undef EX
  #undef VRD
  #undef VRD2
  #undef KRD
  #undef MF32
  #undef STEP
  #undef ENDW
  {auto rr=__builtin_amdgcn_permlane32_swap(__float_as_uint(l_reg),__float_as_uint(l_reg),false,false);l_reg=__uint_as_float(rr[0])+__uint_as_float(rr[1]);}
  { int le=lane; asm volatile("":"+v"(le)); const int r32e=le&31,hie=le>>5;
  float*wse=(float*)(shm+LDS_WS)+wid*64;
  if(hie==0)wse[32+r32e]=l_reg;asm volatile("s_waitcnt lgkmcnt(0)":::"memory");
  float rli[16];
  #pragma unroll
  for(int r=0;r<16;++r)rli[r]=__builtin_amdgcn_rcpf(wse[32+crow(r,hie)]);
  bf16*Ow=O+(rowbase+q0+wid*QBLK)*OP+ocol;
  { bf16*stg=(bf16*)(shm+LDS_OST)+wid*2048;
    #pragma unroll
    for(int hf=0;hf<2;++hf){
      #pragma unroll
      for(int r=0;r<16;++r){const int orow=crow(r,hie);
        #pragma unroll
        for(int d0=0;d0<2;++d0)stg[orow*64+d0*32+r32e]=__float2bfloat16(o[2*hf+d0][r]*rli[r]);}
      asm volatile("s_waitcnt lgkmcnt(0)":::"memory");
      #pragma unroll
      for(int i=0;i<4;++i){const int row=i*8+(le>>3),ch=le&7; const u32x4 v=*(const u32x4*)(stg+row*64+ch*8); ATTN_STORE16(Ow+(long)row*OP+hf*64+ch*8,v);}
      asm volatile("s_waitcnt lgkmcnt(0)":::"memory"); } } }
  asm volatile("s_waitcnt lgkmcnt(0)\n\ts_barrier":::"memory");
  #undef DMA_K
  #undef DMA_V
  #undef CMASK
  #undef START
  #undef RESC
  #undef ROT
}
constexpr int ATTN_LDS_BYTES=LDS_BYTES;
struct AttnTensors { const bf16* Q; const bf16* K; const bf16* V; bf16* O; };
struct AttnUnit { int bh; int qb; };
struct StaticOrder {
  int vcu,G;
  __device__ __forceinline__ explicit StaticOrder(int grid,int v):vcu(v),G(grid){}
  __device__ __forceinline__ bool next(int i,AttnUnit&u)const{ const int p=vcu+(i>>1)*G; if(p>=BATCH*NVH*8)return false; const int s=p&7; u.bh=p>>3; u.qb=(i&1)?15-s:s; return true; }
  __device__ __forceinline__ void a_ready(const AttnUnit&)const{}
  __device__ __forceinline__ void done(const AttnUnit&)const{}
};
template<class Sched,int THRL=8> __device__ __forceinline__ void attn_phase(char*lds,const AttnTensors&T,const Sched&S){
  AttnUnit u;
  for(int i=0;S.next(i,u);++i){ S.a_ready(u); { const int b_=u.bh>>4,hc_=u.bh&15,h_=hc_>>1,c_=hc_&1; attn_unit<THRL>(b_,h_*128+c_*64,h_*128,hc_*128,u.qb,T.Q,T.K,T.V,T.O,lds); } S.done(u); }
}
#undef SBAR
#undef WAIT_BAR
}
namespace cg = cooperative_groups;
constexpr int NWAVES = 8;
#ifndef MK_N_LAUNCHES
#define MK_N_LAUNCHES 1
#endif
constexpr int N_PHASES = 9;
constexpr int N_LAUNCHES = MK_N_LAUNCHES;

constexpr int BATCH = 16, T = 4096, D = 1024, NCOLS = 10240;
constexpr int M = BATCH * T;
constexpr float NORM_EPS = 1e-6f, HEAD_EPS = 1e-5f, LAM_INIT = 0.2f;

constexpr size_t MiB = 1u << 20;
constexpr size_t WS_WIN = 2 * MiB, WS_WA = 22 * MiB, WS_WB = 24 * MiB, WS_WO = 26 * MiB;
constexpr size_t WS_XN = 32 * MiB, WS_SB = 160 * MiB, WS_CX = 288 * MiB, WS_Q = 416 * MiB, WS_K = 544 * MiB, WS_V = 672 * MiB, WS_ZB = 800 * MiB, WS_END = 928 * MiB;
constexpr size_t WS_AA = WS_XN;
constexpr size_t WS_O = WS_XN;
constexpr size_t WS_GAYA = WS_CX;
constexpr size_t WS_AB = WS_ZB;
constexpr size_t WS_MM = WS_K;

constexpr int RING_OFF = 0, RING_BYTES = 131072;
constexpr int LDS_BYTES = 147456;

#define GAS __attribute__((address_space(1)))
#define LAS __attribute__((address_space(3)))
typedef unsigned short bf16;
typedef unsigned v4u __attribute__((ext_vector_type(4)));
typedef float f32x4 __attribute__((ext_vector_type(4)));
#define LDS_WAIT() asm volatile("s_waitcnt lgkmcnt(0)" ::: "memory")
__device__ __forceinline__ unsigned f2bf(float f) { unsigned u = __builtin_bit_cast(unsigned, f); return (u + 0x7fffu + ((u >> 16) & 1u)) >> 16; }
__device__ __forceinline__ unsigned pk2(float lo, float hi) { return f2bf(lo) | (f2bf(hi) << 16); }
__device__ __forceinline__ float blo(unsigned w) { return __builtin_bit_cast(float, w << 16); }
__device__ __forceinline__ float bhi(unsigned w) { return __builtin_bit_cast(float, w & 0xffff0000u); }

struct Frame {
    LAS unsigned char* lds;
    int tid, lane, wave, vcu, G;
};
__device__ __forceinline__ float wave_sum(float v) {
#pragma unroll
    for (int o = 1; o < 64; o <<= 1) v += __shfl_xor(v, o);
    return v;
}
__device__ __forceinline__ int win_dest_row(int n) {
    if (n >= 4096) return n;
    const int q = n >> 10, ch = n & 1023, pn = ch >> 6, c6 = ch & 63, wc = c6 >> 4, fq = (c6 >> 2) & 3, j = c6 & 3;
    return 256 * pn + 128 * (q >> 1) + 32 * wc + 8 * fq + 4 * (q & 1) + j;
}
template <bool PERMCONV>
__device__ __forceinline__ void p0_transpose_item(const float* W, int K, int N, bf16* WT, LAS float* scr, int item, int lane) {
    const int nblk = N / 32, kb = item / nblk, nb = item % nblk, k0 = 64 * kb, n0 = 32 * nb;
#pragma unroll 8
    for (int i = 0; i < 32; ++i) { const int kk = 2 * i + (lane >> 5); scr[kk * 33 + (lane & 31)] = W[(size_t)(k0 + kk) * N + n0 + (lane & 31)]; }
    LDS_WAIT(); asm volatile("" ::: "memory");
    const int c = lane & 7;
#pragma unroll
    for (int j = 0; j < 4; ++j) { const int n = (lane >> 3) + 8 * j; const LAS float* s = scr + (8 * c) * 33 + n;
        v4u o; o.x = pk2(s[0 * 33], s[1 * 33]); o.y = pk2(s[2 * 33], s[3 * 33]); o.z = pk2(s[4 * 33], s[5 * 33]); o.w = pk2(s[6 * 33], s[7 * 33]);
        const int dr = PERMCONV ? win_dest_row(n0 + n) : (n0 + n);
        *(GAS v4u*)(WT + (size_t)dr * K + k0 + 8 * c) = o; }
    LDS_WAIT(); asm volatile("" ::: "memory");
}
template <int NR>
__device__ __forceinline__ void rms_rows_to_bf16(int lane, const float* xrow, size_t rstride, const float* w, bf16* orow) {
    f32x4 v[NR][4]; float s2[NR];
#pragma unroll
    for (int r = 0; r < NR; ++r) { const GAS f32x4* xr = (const GAS f32x4*)(xrow + r * rstride) + lane;
#pragma unroll
        for (int j = 0; j < 4; ++j) v[r][j] = xr[64 * j]; }
    const GAS f32x4* wr = (const GAS f32x4*)w + lane; f32x4 ww[4];
#pragma unroll
    for (int j = 0; j < 4; ++j) ww[j] = wr[64 * j];
#pragma unroll
    for (int r = 0; r < NR; ++r) { s2[r] = 0.f;
#pragma unroll
        for (int j = 0; j < 4; ++j) s2[r] += (v[r][j].x * v[r][j].x + v[r][j].y * v[r][j].y) + (v[r][j].z * v[r][j].z + v[r][j].w * v[r][j].w); }
#pragma unroll
    for (int o = 1; o < 64; o <<= 1)
#pragma unroll
        for (int r = 0; r < NR; ++r) s2[r] += __shfl_xor(s2[r], o);
#pragma unroll
    for (int r = 0; r < NR; ++r) { const float rstd = 1.f / sqrtf(s2[r] * (1.f / D) + NORM_EPS);
        GAS unsigned long long* o8 = (GAS unsigned long long*)(orow + r * rstride) + lane;
#pragma unroll
        for (int j = 0; j < 4; ++j)
            o8[64 * j] = (unsigned long long)pk2(v[r][j].x * rstd * ww[j].x, v[r][j].y * rstd * ww[j].y) | ((unsigned long long)pk2(v[r][j].z * rstd * ww[j].z, v[r][j].w * rstd * ww[j].w) << 32); }
}
template <int NR>
__device__ __forceinline__ void rms_rows_f32(int lane, const float* xrow, size_t rstride, const float* w, float* orow) {
    f32x4 v[NR][4]; float s2[NR];
#pragma unroll
    for (int r = 0; r < NR; ++r) { const GAS f32x4* xr = (const GAS f32x4*)(xrow + r * rstride) + lane;
#pragma unroll
        for (int j = 0; j < 4; ++j) v[r][j] = xr[64 * j]; }
    const GAS f32x4* wr = (const GAS f32x4*)w + lane; f32x4 ww[4];
#pragma unroll
    for (int j = 0; j < 4; ++j) ww[j] = wr[64 * j];
#pragma unroll
    for (int r = 0; r < NR; ++r) { s2[r] = 0.f;
#pragma unroll
        for (int j = 0; j < 4; ++j) s2[r] += (v[r][j].x * v[r][j].x + v[r][j].y * v[r][j].y) + (v[r][j].z * v[r][j].z + v[r][j].w * v[r][j].w); }
#pragma unroll
    for (int o = 1; o < 64; o <<= 1)
#pragma unroll
        for (int r = 0; r < NR; ++r) s2[r] += __shfl_xor(s2[r], o);
#pragma unroll
    for (int r = 0; r < NR; ++r) { const float rstd = 1.f / sqrtf(s2[r] * (1.f / D) + NORM_EPS);
        GAS f32x4* o = (GAS f32x4*)(orow + r * rstride) + lane;
#pragma unroll
        for (int j = 0; j < 4; ++j) o[64 * j] = v[r][j] * rstd * ww[j]; }
}

struct Args { const float* in[14]; float* out; unsigned char* ws; int ph_lo, ph_hi; };
__device__ __forceinline__ int opq(int k) { asm volatile("" : "+s"(k)); return k; }
__device__ __forceinline__ size_t opq64(size_t k) { asm volatile("" : "+s"(k)); return k; }
__global__ void __launch_bounds__(NWAVES * 64, 2) hyb_fwd(Args args) {
    __builtin_assume(__builtin_amdgcn_workitem_id_y() == 0); __builtin_assume(__builtin_amdgcn_workitem_id_z() == 0);
    extern __shared__ __attribute__((aligned(16))) unsigned char lds[];
    Frame F;
    F.lds = (LAS unsigned char*)lds;
    F.tid = threadIdx.x; F.lane = F.tid & 63; F.wave = __builtin_amdgcn_readfirstlane(F.tid >> 6);
    F.G = gridDim.x; { const int bx = blockIdx.x; F.vcu = (F.G % 8 == 0) ? (bx % 8) * (F.G / 8) + bx / 8 : bx; }
#define KIN(k) (args.in[opq(k)])
#define WSP(off) ((bf16*)(args.ws + (size_t)opq64(off)))
    const int lo = args.ph_lo, hi = args.ph_hi;
#define IN(k) (lo <= (k) && (k) < hi)
#define SEAM(k) do { if (IN(k) && IN((k) + 1)) { cg::this_grid().sync(); } } while (0)
    const int gw = F.vcu * NWAVES + F.wave, NGW = F.G * NWAVES;

    if (IN(0)) {
        LAS float* scr = (LAS float*)(F.lds + RING_OFF + F.wave * 16384);
        const float* x = KIN(0); const float* norm_w = KIN(1); const float* w_in = KIN(2); const float* w_out_a = KIN(4); const float* w_out_b = KIN(10); const float* w_o = KIN(12);
        bf16* Win_t = WSP(WS_WIN); bf16* Wa_t = WSP(WS_WA); bf16* Wb_t = WSP(WS_WB); bf16* Wo_t = WSP(WS_WO); bf16* XN = WSP(WS_XN);
        constexpr int I_IN = (D / 64) * (NCOLS / 32), I_SQ = (D / 64) * (D / 32);
        constexpr int NITEMS = I_IN + 3 * I_SQ;
        for (int it = gw; it < NITEMS; it += NGW) {
            int r = it;
            if (r < I_IN) { p0_transpose_item<true>(w_in, D, NCOLS, Win_t, scr, r, F.lane); continue; } r -= I_IN;
            if (r < I_SQ) { p0_transpose_item<false>(w_out_a, D, D, Wa_t, scr, r, F.lane); continue; } r -= I_SQ;
            if (r < I_SQ) { p0_transpose_item<false>(w_out_b, D, D, Wb_t, scr, r, F.lane); continue; } r -= I_SQ;
            p0_transpose_item<false>(w_o, D, D, Wo_t, scr, r, F.lane);
        }
        for (int m = gw; m < M; m += 4 * NGW) rms_rows_to_bf16<4>(F.lane, x + (size_t)m * D, (size_t)NGW * D, norm_w, XN + (size_t)m * D);
    }
    SEAM(0);
    if (IN(1)) {
        bf16* XN = WSP(WS_XN); bf16* Win_t = WSP(WS_WIN); bf16* CX = WSP(WS_CX); bf16* SB = WSP(WS_SB); bf16* QB_ = WSP(WS_Q); bf16* GT = (bf16*)args.out; const float* b_gate = KIN(11);
        pg8::Gemm g{XN, Win_t, M, NCOLS, D}; pg8::StaticOrder S; S.init(M, NCOLS, F.G, (int)blockIdx.x);
        pg8::EpiInProj E{CX, SB, QB_, (size_t)(WS_K - WS_Q) / 2, GT, b_gate, attn_body::C2};
        pg8::gemm_phase<pg8::EpiInProj, pg8::StaticOrder, PG8_ALIGN, PG8_SP2>(F.lds + RING_OFF, g, S, E);
    }
    SEAM(1);
    if (IN(2)) {
        const int cgp = F.tid & 127, rs = F.tid >> 7, ch = cgp * 8;
        const float* conv_w = KIN(3); bf16* CX = WSP(WS_CX); bf16* SB = WSP(WS_SB); bf16* AA = WSP(WS_AA);
        float w0[8], w1[8], w2[8];
#pragma unroll
        for (int e = 0; e < 8; ++e) { w0[e] = conv_w[ch + e]; w1[e] = conv_w[1024 + ch + e]; w2[e] = conv_w[2048 + ch + e]; }
        for (int item = F.vcu; item < M / 64; item += F.G) {
            const int r0 = item * 64 + rs * 16;
            const bool first = (r0 % T) == 0;
            v4u p2 = (v4u){0u, 0u, 0u, 0u}, p1 = (v4u){0u, 0u, 0u, 0u};
            if (!first) { p2 = *(const GAS v4u*)(CX + (size_t)(r0 - 2) * 1024 + ch); p1 = *(const GAS v4u*)(CX + (size_t)(r0 - 1) * 1024 + ch); }
#pragma unroll
            for (int hb = 0; hb < 2; ++hb) {
                v4u c[8], s[8];
#pragma unroll
                for (int i = 0; i < 8; ++i) { c[i] = *(const GAS v4u*)(CX + (size_t)(r0 + hb * 8 + i) * 1024 + ch); s[i] = *(const GAS v4u*)(SB + (size_t)(r0 + hb * 8 + i) * 1024 + ch); }
#pragma unroll
                for (int i = 0; i < 8; ++i) {
                    const v4u cur = c[i]; v4u o;
#pragma unroll
                    for (int q = 0; q < 4; ++q) {
                        const float ylo = w0[2 * q] * blo(p2[q]) + w1[2 * q] * blo(p1[q]) + w2[2 * q] * blo(cur[q]);
                        const float yhi = w0[2 * q + 1] * bhi(p2[q]) + w1[2 * q + 1] * bhi(p1[q]) + w2[2 * q + 1] * bhi(cur[q]);
                        o[q] = pk2(ylo * blo(s[i][q]), yhi * bhi(s[i][q]));
                    }
                    *(GAS v4u*)(AA + (size_t)(r0 + hb * 8 + i) * 1024 + ch) = o;
                    p2 = p1; p1 = cur;
                }
            }
        }
    }
    SEAM(2);
    if (IN(3)) {
        bf16* AA = WSP(WS_AA); bf16* Wa_t = WSP(WS_WA); bf16* GAYA = WSP(WS_GAYA); bf16* GT = (bf16*)args.out;
        pg8::Gemm g{AA, Wa_t, M, D, D}; pg8::StaticOrder S; S.init(M, D, F.G, (int)blockIdx.x);
        pg8::EpiGate<false> E{GAYA, GT, nullptr};
        pg8::gemm_phase<pg8::EpiGate<false>, pg8::StaticOrder, PG8_ALIGN, PG8_SP2>(F.lds + RING_OFF, g, S, E);
    }
    SEAM(3);
    if (IN(4)) {
        bf16* QB_ = WSP(WS_Q); bf16* KB = WSP(WS_K); bf16* VB = WSP(WS_V); bf16* OB = WSP(WS_O);
        const attn_body::AttnTensors AT{(const attn_body::bf16*)QB_, (const attn_body::bf16*)KB, (const attn_body::bf16*)VB, (attn_body::bf16*)OB};
        const attn_body::StaticOrder S((int)F.G, F.vcu);
        attn_body::attn_phase<attn_body::StaticOrder>((char*)lds + RING_OFF, AT, S);
    }
    SEAM(4);
    if (IN(5)) {
        const float* lq1 = KIN(5); const float* lk1 = KIN(6); const float* lq2 = KIN(7); const float* lk2 = KIN(8); const float* head_w = KIN(9);
        bf16* OB = WSP(WS_O); bf16* ZB = WSP(WS_ZB); bf16* AB = WSP(WS_AB);
        const float d1 = lq1[F.lane] * lk1[F.lane], d2 = lq2[F.lane] * lk2[F.lane];
        const float lam = __expf(wave_sum(d1)) - __expf(wave_sum(d2)) + LAM_INIT;
        const int rsub = F.tid >> 7, l = F.tid & 127, h = l >> 4, j0 = (l & 15) * 8;
        float hw[8];
#pragma unroll
        for (int e = 0; e < 8; ++e) hw[e] = head_w[j0 + e] * (1.0f - LAM_INIT);
        for (int item = F.vcu; item < M / 32; item += F.G) {
#pragma unroll 2
            for (int ps = 0; ps < 8; ++ps) {
                const size_t row = (size_t)item * 32 + ps * 4 + rsub;
                const v4u o1 = *(const GAS v4u*)(OB + row * 2048 + (h * 2) * 128 + j0), o2 = *(const GAS v4u*)(OB + row * 2048 + (h * 2 + 1) * 128 + j0);
                const v4u z = *(const GAS v4u*)(ZB + row * 1024 + h * 128 + j0);
                float d[8]; float ss = 0.f;
#pragma unroll
                for (int q = 0; q < 4; ++q) { d[2 * q] = blo(o1[q]) - lam * blo(o2[q]); d[2 * q + 1] = bhi(o1[q]) - lam * bhi(o2[q]); ss += d[2 * q] * d[2 * q] + d[2 * q + 1] * d[2 * q + 1]; }
                ss += __shfl_xor(ss, 1); ss += __shfl_xor(ss, 2); ss += __shfl_xor(ss, 4); ss += __shfl_xor(ss, 8);
                const float rstd = 1.f / sqrtf(ss * (1.f / 128.f) + HEAD_EPS);
                v4u o;
#pragma unroll
                for (int q = 0; q < 4; ++q) o[q] = pk2(d[2 * q] * rstd * hw[2 * q] * pg8::silu_f(blo(z[q])), d[2 * q + 1] * rstd * hw[2 * q + 1] * pg8::silu_f(bhi(z[q])));
                *(GAS v4u*)(AB + row * 1024 + h * 128 + j0) = o;
            }
        }
    }
    SEAM(5);
    if (IN(6)) {
        bf16* AB = WSP(WS_AB); bf16* Wb_t = WSP(WS_WB); bf16* MM = WSP(WS_MM); bf16* GAYA = WSP(WS_GAYA); bf16* GT = (bf16*)args.out;
        pg8::Gemm g{AB, Wb_t, M, D, D}; pg8::StaticOrder S; S.init(M, D, F.G, (int)blockIdx.x);
        pg8::EpiGate<true> E{MM, GT + 1024, GAYA};
        pg8::gemm_phase<pg8::EpiGate<true>, pg8::StaticOrder, PG8_ALIGN, PG8_SP2>(F.lds + RING_OFF, g, S, E);
    }
    SEAM(6);
    if (IN(7)) {
        bf16* MM = WSP(WS_MM); bf16* Wo_t = WSP(WS_WO); float* out = args.out; const float* x = KIN(0);
        pg8::Gemm g{MM, Wo_t, M, D, D}; pg8::StaticOrder S; S.init(M, D, F.G, (int)blockIdx.x);
        pg8::EpiResF32 E{out, x};
        pg8::gemm_phase<pg8::EpiResF32, pg8::StaticOrder, PG8_ALIGN, PG8_SP2>(F.lds + RING_OFF, g, S, E);
    }
    SEAM(7);
    if (IN(8)) {
        float* out = args.out; const float* final_w = KIN(13);
        for (int m = gw; m < M; m += 4 * NGW) rms_rows_f32<4>(F.lane, out + (size_t)m * D, (size_t)NGW * D, final_w, out + (size_t)m * D);
    }
#undef IN
#undef SEAM
}

extern "C" void kernel_launch(void* const* d_in, const int* in_sizes, int n_in, void* d_out, int out_size, void* d_ws, size_t ws_size, hipStream_t stream) {
    static int grid = 0;
    if (grid == 0) {
        if (n_in != 14 || in_sizes[0] != M * D || out_size != M * D || ws_size < WS_END) { fprintf(stderr, "kernel_launch: unexpected shapes: n_in %d in0 %d out %d ws %zu\n", n_in, n_in > 0 ? in_sizes[0] : -1, out_size, ws_size); grid = -1; return; }
        int dev = 0, cus = 0, per_cu = 0;
        if (hipGetDevice(&dev) != hipSuccess || hipDeviceGetAttribute(&cus, hipDeviceAttributeMultiprocessorCount, dev) != hipSuccess) { grid = -1; return; }
        if (hipFuncSetAttribute((const void*)hyb_fwd, hipFuncAttributeMaxDynamicSharedMemorySize, LDS_BYTES) != hipSuccess) { fprintf(stderr, "kernel_launch: hipFuncSetAttribute failed\n"); grid = -1; return; }
        if (hipOccupancyMaxActiveBlocksPerMultiprocessor(&per_cu, (const void*)hyb_fwd, NWAVES * 64, LDS_BYTES) != hipSuccess || per_cu < 1) { fprintf(stderr, "kernel_launch: occupancy query says %d\n", per_cu); per_cu = 1; }
        (void)hipGetLastError();
        grid = cus;
    }
    if (grid < 0) return;
    Args a{};
    for (int i = 0; i < 14; ++i) a.in[i] = (const float*)d_in[i];
    a.out = (float*)d_out; a.ws = (unsigned char*)d_ws;
    if (N_LAUNCHES == 1) {
        a.ph_lo = 0; a.ph_hi = N_PHASES;
        void* kargs[] = {&a};
        const hipError_t e = hipLaunchCooperativeKernel((const void*)hyb_fwd, dim3(grid), dim3(NWAVES * 64), kargs, LDS_BYTES, stream);
        if (e != hipSuccess) fprintf(stderr, "kernel_launch: cooperative launch failed: %s (grid %d)\n", hipGetErrorString(e), grid);
    } else {
        for (int li = 0; li < N_PHASES; ++li) {
            a.ph_lo = li; a.ph_hi = li + 1;
            hipLaunchKernelGGL(hyb_fwd, dim3(grid), dim3(NWAVES * 64), LDS_BYTES, stream, a);
        }
    }
}
```

```cpp
#include <hip/hip_runtime.h>
#include <cstdio>
#include <cstdint>
#include <hip/hip_cooperative_groups.h>
namespace pg8 {
#define PG8_LAS __attribute__((address_space(3)))
typedef unsigned short bf16_t;
typedef short bf16x8 __attribute__((ext_vector_type(8)));
typedef float f32x4 __attribute__((ext_vector_type(4)));
typedef unsigned u32x4 __attribute__((ext_vector_type(4)));
constexpr int BM = 256, BK = 64, HALF = 128, HTB = HALF * BK * 2  , STAGE_BYTES = 8 * HTB, NXCD = 8, WGM = 8;

__host__ __device__ __forceinline__ int lds_byte(int r, int c) { const int st = (r >> 4) * 2 + (c >> 5), rr = r & 15, cc = c & 31, ob = rr * 64 + cc * 2; return st * 1024 + (ob ^ (((ob >> 9) & 1) << 5)); }
__host__ __device__ __forceinline__ void stage_rc(int b, int& R, int& C) { const int st = b / 1024, sb = b % 1024, swz = sb ^ (((sb >> 9) & 1) << 5); R = (st >> 1) * 16 + swz / 64; C = (st & 1) * 32 + (swz % 64) / 2; }
__host__ __device__ __forceinline__ int perm32(int rho) { const int n = rho >> 4, i = rho & 15; return 8 * (i >> 2) + 4 * n + (i & 3); }

struct Unit { int pm, pn, src; };
struct Gemm { const bf16_t* A; const bf16_t* Bt; int M, N, K; const bf16_t* A2; const bf16_t* Bt2; };

struct StaticOrder {
    int nM, nN, nwg, G, c;
    __host__ __device__ void init(int M, int N, int G_, int c_) { nM = M / BM; nN = N / BM; nwg = nM * nN; G = G_; c = c_; }
    __host__ __device__ bool next(int i, Unit& u) const {
        const long L = (long)i * G + c; if (L >= nwg) return false;
        int wgid = (int)L; { const int q = nwg / NXCD, r = nwg % NXCD, xcd = wgid % NXCD, off = wgid / NXCD; wgid = (xcd < r ? xcd * (q + 1) : r * (q + 1) + (xcd - r) * q) + off; }
        const int nig = WGM * nN, gid = wgid / nig, fm = gid * WGM, gsz = (nM - fm) < WGM ? (nM - fm) : WGM;
        u.pm = fm + ((wgid % nig) % gsz); u.pn = (wgid % nig) / gsz; u.src = 0; return true;
    }
    __device__ __forceinline__ void a_ready(const Unit&) const {}
    __device__ __forceinline__ void done(const Unit&) const {}
};

struct DualOrder {
    StaticOrder S0;
    __host__ __device__ void init(int M, int N, int G_, int c_) { S0.init(M, N, G_, c_); }
    __host__ __device__ bool next(int i, Unit& u) const { if (!S0.next(i >> 1, u)) return false; u.src = i & 1; return true; }
    __device__ __forceinline__ void a_ready(const Unit&) const {}
    __device__ __forceinline__ void done(const Unit&) const {}
};
typedef float cvt_f32x2_t __attribute__((ext_vector_type(2))); typedef __bf16 cvt_bf16x2_t __attribute__((ext_vector_type(2)));
__device__ __forceinline__ unsigned cvt_pk_bf16(float lo, float hi) { cvt_f32x2_t v = {lo, hi}; cvt_bf16x2_t b = __builtin_convertvector(v, cvt_bf16x2_t); return __builtin_bit_cast(unsigned, b); }
typedef float f32x2 __attribute__((ext_vector_type(2)));
__device__ __forceinline__ float sigmoid_f(float x) { return __builtin_amdgcn_rcpf(1.0f + __builtin_amdgcn_exp2f(-1.4426950408889634f * x)); }
__device__ __forceinline__ float silu_f(float x) { return x * sigmoid_f(x); }
__device__ __forceinline__ float bf_lo(unsigned w) { return __builtin_bit_cast(float, w << 16); }
__device__ __forceinline__ float bf_hi(unsigned w) { return __builtin_bit_cast(float, w & 0xffff0000u); }
typedef unsigned u32x2 __attribute__((ext_vector_type(2)));

struct EpiInProj {
    static constexpr bool PERM = true, AFTER_DRAIN = false, DUAL = false;
    bf16_t* CX; bf16_t* SB; bf16_t* QKVZ; size_t stride; bf16_t* GT; const float* bgate; float qscale;
    __device__ __forceinline__ void operator()(const f32x4 (&acc)[2][2][4][2], const Unit& u, int wr, int wc, int fr, int fq) const {
        const int row0 = u.pm * BM + wr * 64 + fr;
        if (u.pn < 16) {
            const int ch = u.pn * 64 + wc * 16 + fq * 4;
#pragma unroll
            for (int ai = 0; ai < 2; ++ai)
#pragma unroll
                for (int m = 0; m < 4; ++m) {
                    const size_t off = (size_t)(row0 + ai * HALF + m * 16) * 1024 + ch;
                    const f32x4 xa = acc[ai][0][m][0], cg = acc[ai][0][m][1], bg = acc[ai][1][m][0], za = acc[ai][1][m][1];
                    const f32x4 cx = xa * cg;
                    f32x4 sb; sb[0] = silu_f(za[0]) * bg[0]; sb[1] = silu_f(za[1]) * bg[1]; sb[2] = silu_f(za[2]) * bg[2]; sb[3] = silu_f(za[3]) * bg[3];
                    u32x2 w0, w1; w0.x = cvt_pk_bf16(cx[0], cx[1]); w0.y = cvt_pk_bf16(cx[2], cx[3]); w1.x = cvt_pk_bf16(sb[0], sb[1]); w1.y = cvt_pk_bf16(sb[2], sb[3]);
                    *(u32x2*)(CX + off) = w0; *(u32x2*)(SB + off) = w1;
                }
        } else if (u.pn < 32) {
            const int t = (u.pn - 16) >> 2; bf16_t* base = QKVZ + (size_t)t * stride; const float sc = (t == 0) ? qscale : 1.0f;
            const int col0 = ((u.pn - 16) & 3) * BM + wc * 32 + 8 * fq;
#pragma unroll
            for (int ai = 0; ai < 2; ++ai)
#pragma unroll
                for (int m = 0; m < 4; ++m) { bf16_t* rowp = base + (size_t)(row0 + ai * HALF + m * 16) * 1024 + col0;
#pragma unroll
                    for (int bj = 0; bj < 2; ++bj) { const f32x4 v0 = acc[ai][bj][m][0] * sc, v1 = acc[ai][bj][m][1] * sc;
                        u32x4 w; w.x = cvt_pk_bf16(v0[0], v0[1]); w.y = cvt_pk_bf16(v0[2], v0[3]); w.z = cvt_pk_bf16(v1[0], v1[1]); w.w = cvt_pk_bf16(v1[2], v1[3]);
                        *(u32x4*)(rowp + bj * HALF) = w; } }
        } else {
            const int col0 = (u.pn - 32) * BM + wc * 32 + 8 * fq;
            f32x4 bv[2][2];
#pragma unroll
            for (int bj = 0; bj < 2; ++bj)
#pragma unroll
                for (int n = 0; n < 2; ++n) bv[bj][n] = *(const f32x4*)(bgate + col0 + bj * HALF + 4 * n);
#pragma unroll
            for (int ai = 0; ai < 2; ++ai)
#pragma unroll
                for (int m = 0; m < 4; ++m) { bf16_t* rowp = GT + (size_t)(row0 + ai * HALF + m * 16) * 2048 + col0;
#pragma unroll
                    for (int bj = 0; bj < 2; ++bj) { const f32x4 a0 = acc[ai][bj][m][0] + bv[bj][0], a1 = acc[ai][bj][m][1] + bv[bj][1];
                        u32x4 w; w.x = cvt_pk_bf16(sigmoid_f(a0[0]), sigmoid_f(a0[1])); w.y = cvt_pk_bf16(sigmoid_f(a0[2]), sigmoid_f(a0[3]));
                        w.z = cvt_pk_bf16(sigmoid_f(a1[0]), sigmoid_f(a1[1])); w.w = cvt_pk_bf16(sigmoid_f(a1[2]), sigmoid_f(a1[3]));
                        *(u32x4*)(rowp + bj * HALF) = w; } }
        }
    }
};
struct EpiDual {
    static constexpr bool PERM = true, AFTER_DRAIN = false, DUAL = true;
    bf16_t* O; const bf16_t* G;
    __device__ __forceinline__ void mid(f32x4 (&acc)[2][2][4][2], const Unit& u, int wr, int wc, int fr, int fq) const {
        const int row0 = u.pm * BM + wr * 64 + fr, col0 = u.pn * BM + wc * 32 + 8 * fq;
#pragma unroll
        for (int ai = 0; ai < 2; ++ai)
#pragma unroll
            for (int mp = 0; mp < 2; ++mp) {
                u32x4 ga[2][2], gb[2][2];
#pragma unroll
                for (int mm = 0; mm < 2; ++mm)
#pragma unroll
                    for (int bj = 0; bj < 2; ++bj) { const bf16_t* gp = G + (size_t)(row0 + ai * HALF + (mp * 2 + mm) * 16) * 2048 + col0 + bj * HALF;
                        ga[mm][bj] = *(const u32x4*)gp; gb[mm][bj] = *(const u32x4*)(gp + 1024); }
#pragma unroll
                for (int mm = 0; mm < 2; ++mm)
#pragma unroll
                    for (int bj = 0; bj < 2; ++bj) { const u32x4 a = ga[mm][bj], b = gb[mm][bj]; const int m = mp * 2 + mm;
#define RT(x, y) ((x) * __builtin_amdgcn_rcpf(__builtin_fmaxf((y), 1e-20f)))
                        acc[ai][bj][m][0][0] *= RT(bf_lo(a.x), bf_lo(b.x)); acc[ai][bj][m][0][1] *= RT(bf_hi(a.x), bf_hi(b.x)); acc[ai][bj][m][0][2] *= RT(bf_lo(a.y), bf_lo(b.y)); acc[ai][bj][m][0][3] *= RT(bf_hi(a.y), bf_hi(b.y));
                        acc[ai][bj][m][1][0] *= RT(bf_lo(a.z), bf_lo(b.z)); acc[ai][bj][m][1][1] *= RT(bf_hi(a.z), bf_hi(b.z)); acc[ai][bj][m][1][2] *= RT(bf_lo(a.w), bf_lo(b.w)); acc[ai][bj][m][1][3] *= RT(bf_hi(a.w), bf_hi(b.w));
#undef RT
                    }
                asm volatile("" ::: "memory"); }
    }
    __device__ __forceinline__ void operator()(const f32x4 (&acc)[2][2][4][2], const Unit& u, int wr, int wc, int fr, int fq) const {
        const int row0 = u.pm * BM + wr * 64 + fr, col0 = u.pn * BM + wc * 32 + 8 * fq;
#pragma unroll
        for (int ai = 0; ai < 2; ++ai) {
            u32x4 g[4][2];
#pragma unroll
            for (int m = 0; m < 4; ++m)
#pragma unroll
                for (int bj = 0; bj < 2; ++bj) g[m][bj] = *(const u32x4*)(G + (size_t)(row0 + ai * HALF + m * 16) * 2048 + 1024 + col0 + bj * HALF);
#pragma unroll
            for (int m = 0; m < 4; ++m)
#pragma unroll
                for (int bj = 0; bj < 2; ++bj) { const size_t row = (size_t)(row0 + ai * HALF + m * 16); const int c = col0 + bj * HALF;
                    const u32x4 gv = g[m][bj]; const f32x4 a0 = acc[ai][bj][m][0], a1 = acc[ai][bj][m][1];
                    u32x4 w; w.x = cvt_pk_bf16(a0[0] * bf_lo(gv.x), a0[1] * bf_hi(gv.x)); w.y = cvt_pk_bf16(a0[2] * bf_lo(gv.y), a0[3] * bf_hi(gv.y));
                    w.z = cvt_pk_bf16(a1[0] * bf_lo(gv.z), a1[1] * bf_hi(gv.z)); w.w = cvt_pk_bf16(a1[2] * bf_lo(gv.w), a1[3] * bf_hi(gv.w));
                    *(u32x4*)(O + row * 1024 + c) = w; }
            asm volatile("" ::: "memory"); }
    }
};
struct EpiResF32 {
    static constexpr bool PERM = true, AFTER_DRAIN = false, DUAL = false;
    float* O; const float* X;
    __device__ __forceinline__ void operator()(const f32x4 (&acc)[2][2][4][2], const Unit& u, int wr, int wc, int fr, int fq) const {
        const int row0 = u.pm * BM + wr * 64 + fr, col0 = u.pn * BM + wc * 32 + 8 * fq;
#pragma unroll
        for (int ai = 0; ai < 2; ++ai)
#pragma unroll
            for (int mp = 0; mp < 2; ++mp) {
                f32x4 xv[2][2][2];
#pragma unroll
                for (int mm = 0; mm < 2; ++mm)
#pragma unroll
                    for (int bj = 0; bj < 2; ++bj)
#pragma unroll
                        for (int n = 0; n < 2; ++n) xv[mm][bj][n] = *(const f32x4*)(X + (size_t)(row0 + ai * HALF + (mp * 2 + mm) * 16) * 1024 + col0 + bj * HALF + 4 * n);
#pragma unroll
                for (int mm = 0; mm < 2; ++mm)
#pragma unroll
                    for (int bj = 0; bj < 2; ++bj)
#pragma unroll
                        for (int n = 0; n < 2; ++n) *(f32x4*)(O + (size_t)(row0 + ai * HALF + (mp * 2 + mm) * 16) * 1024 + col0 + bj * HALF + 4 * n) = xv[mm][bj][n] + acc[ai][bj][mp * 2 + mm][n];
                asm volatile("" ::: "memory"); }
    }
};

template <class Epi, class Sched, bool ALIGN_EPI = false, bool SP2 = false>
__device__ __forceinline__ void gemm_phase(PG8_LAS unsigned char* lds, const Gemm g, const Sched& S, const Epi& E) {
    const int tid = threadIdx.x, wid = __builtin_amdgcn_readfirstlane(tid >> 6), lane = tid & 63, wr = wid >> 2, wc = wid & 3, fr = lane & 15, fq = lane >> 4;
    const int K = g.K, nt = K / BK;
    unsigned voffA[2], voffB[2];
#pragma unroll
    for (int i = 0; i < 2; ++i) { int R, C; stage_rc(tid * 16 + i * 8192, R, C); const int Rb = Epi::PERM ? ((R & ~31) + perm32(R & 31)) : R;
        voffA[i] = (unsigned)(R * K + C) * 2u; voffB[i] = (unsigned)(Rb * K + C) * 2u; }
    const size_t kstep = (size_t)(BK * 2);
    const size_t hstep = (size_t)HALF * K * 2;
    const size_t tstep = 2 * hstep;
    const unsigned ldsw = (unsigned)wid * 1024u;
    const int aoff = lds_byte(wr * 64 + fr, fq * 8), boff = lds_byte(wc * 32 + fr, fq * 8);
#define PG8_SA(b, h) (((b) * 2 + (h)) * HTB)
#define PG8_SB(b, h) ((4 + (b) * 2 + (h)) * HTB)
#define PG8_STAGE(bufoff, gbase, voff) do { _Pragma("unroll") for (int _i = 0; _i < 2; ++_i) \
        __builtin_amdgcn_global_load_lds((const unsigned*)((const char*)(gbase) + (voff)[_i]), (PG8_LAS unsigned*)(lds + (bufoff) + ldsw + _i * 8192), 16, 0, 0); } while (0)
#define PG8_LDA(dst, b, h) do { _Pragma("unroll") for (int m = 0; m < 4; ++m) _Pragma("unroll") for (int k = 0; k < 2; ++k) dst[m][k] = *(const PG8_LAS bf16x8*)(lds + PG8_SA(b, h) + aoff + m * 2048 + k * 1024); } while (0)
#define PG8_LDB(dst, b, h) do { _Pragma("unroll") for (int n = 0; n < 2; ++n) _Pragma("unroll") for (int k = 0; k < 2; ++k) dst[n][k] = *(const PG8_LAS bf16x8*)(lds + PG8_SB(b, h) + boff + n * 2048 + k * 1024); } while (0)
#define PG8_MMA(ai, bj, At, Bt) do { __builtin_amdgcn_s_setprio(1); _Pragma("unroll") for (int m = 0; m < 4; ++m) _Pragma("unroll") for (int n = 0; n < 2; ++n) _Pragma("unroll") for (int k = 0; k < 2; ++k) \
        acc[ai][bj][m][n] = __builtin_amdgcn_mfma_f32_16x16x32_bf16(Bt[n][k], At[m][k], acc[ai][bj][m][n], 0, 0, 0); __builtin_amdgcn_s_setprio(0); } while (0)
#define PG8_WAIT_V(n) asm volatile("s_waitcnt vmcnt(" #n ")" ::: "memory")
#define PG8_WAIT_L(n) asm volatile("s_waitcnt lgkmcnt(" #n ")" ::: "memory")
#define PG8_BAR __builtin_amdgcn_s_barrier()
#define PG8_SCHED __builtin_amdgcn_sched_barrier(0)
    Unit cur, nxt; int ui = 0;
    if (!S.next(0, cur)) return;
    f32x4 acc[2][2][4][2];
#pragma unroll
    for (int a = 0; a < 2; ++a)
#pragma unroll
        for (int b = 0; b < 2; ++b)
#pragma unroll
            for (int m = 0; m < 4; ++m)
#pragma unroll
                for (int n = 0; n < 2; ++n) acc[a][b][m][n] = (f32x4){0.f, 0.f, 0.f, 0.f};
    bf16x8 At[4][2], B0[2][2], B1[2][2];
    const char* cA = (const char*)(cur.src ? g.A2 : g.A) + (size_t)cur.pm * tstep; const char* cB = (const char*)(cur.src ? g.Bt2 : g.Bt) + (size_t)cur.pn * tstep;
    S.a_ready(cur);
    if constexpr (SP2) {
        PG8_STAGE(PG8_SB(0, 0), cB, voffB); PG8_STAGE(PG8_SB(0, 1), cB + hstep, voffB); PG8_STAGE(PG8_SA(0, 0), cA, voffA); PG8_STAGE(PG8_SA(0, 1), cA + hstep, voffA);
        if (wr == 1) PG8_BAR;
        PG8_WAIT_V(2); PG8_BAR;
        PG8_STAGE(PG8_SB(1, 0), cB + kstep, voffB); PG8_STAGE(PG8_SA(1, 0), cA + kstep, voffA); PG8_STAGE(PG8_SB(1, 1), cB + hstep + kstep, voffB);
        PG8_WAIT_V(6); PG8_BAR;
    } else {
        PG8_STAGE(PG8_SB(0, 0), cB, voffB); PG8_STAGE(PG8_SA(0, 0), cA, voffA); PG8_STAGE(PG8_SB(0, 1), cB + hstep, voffB); PG8_STAGE(PG8_SA(0, 1), cA + hstep, voffA);
        if (wr == 1) PG8_BAR;
        PG8_WAIT_V(4); PG8_BAR;
        PG8_STAGE(PG8_SB(1, 0), cB + kstep, voffB); PG8_STAGE(PG8_SA(1, 0), cA + kstep, voffA); PG8_STAGE(PG8_SB(1, 1), cB + hstep + kstep, voffB);
        PG8_WAIT_V(6); PG8_BAR;
    }
    for (;;) {
        const bool has_next = S.next(ui + 1, nxt);
        const char* nA = has_next ? (const char*)(nxt.src ? g.A2 : g.A) + (size_t)nxt.pm * tstep : cA; const char* nB = has_next ? (const char*)(nxt.src ? g.Bt2 : g.Bt) + (size_t)nxt.pn * tstep : cB;
        for (int t = 0; t < nt; t += 2) {
            const bool last = (t == nt - 2);
            const char* a1 = cA + (size_t)(t + 1) * kstep;
            const char* a2 = last ? nA : cA + (size_t)(t + 2) * kstep; const char* b2 = last ? nB : cB + (size_t)(t + 2) * kstep;
            const char* a3 = a2 + kstep; const char* b3 = b2 + kstep;
            if (last && has_next) S.a_ready(nxt);
            if constexpr (SP2) {
            PG8_LDB(B0, 0, 0); PG8_LDB(B1, 0, 1); PG8_SCHED; PG8_LDA(At, 0, 0); PG8_STAGE(PG8_SA(1, 1), a1 + hstep, voffA);
            PG8_WAIT_V(8); PG8_WAIT_L(0); PG8_BAR; PG8_MMA(0, 0, At, B0); PG8_MMA(0, 1, At, B1); PG8_BAR; PG8_SCHED;
            PG8_LDA(At, 0, 1); PG8_STAGE(PG8_SB(0, 0), b2, voffB); PG8_STAGE(PG8_SB(0, 1), b2 + hstep, voffB); PG8_STAGE(PG8_SA(0, 0), a2, voffA);
            PG8_WAIT_V(8); PG8_WAIT_L(0); PG8_BAR; PG8_MMA(1, 0, At, B0); PG8_MMA(1, 1, At, B1); PG8_BAR; PG8_SCHED;
            PG8_LDB(B0, 1, 0); PG8_LDB(B1, 1, 1); PG8_SCHED; PG8_LDA(At, 1, 0); PG8_STAGE(PG8_SA(0, 1), a2 + hstep, voffA);
            PG8_WAIT_V(8); PG8_WAIT_L(0); PG8_BAR; PG8_MMA(0, 0, At, B0); PG8_MMA(0, 1, At, B1); PG8_BAR; PG8_SCHED;
            PG8_LDA(At, 1, 1); PG8_STAGE(PG8_SB(1, 0), b3, voffB); PG8_STAGE(PG8_SB(1, 1), b3 + hstep, voffB); PG8_STAGE(PG8_SA(1, 0), a3, voffA);
            PG8_WAIT_V(8); PG8_WAIT_L(0); PG8_BAR; PG8_MMA(1, 0, At, B0); PG8_MMA(1, 1, At, B1); PG8_BAR; PG8_SCHED;
            } else {
            PG8_LDB(B0, 0, 0); PG8_SCHED; PG8_LDA(At, 0, 0); PG8_STAGE(PG8_SA(1, 1), a1 + hstep, voffA);
            PG8_WAIT_L(8); PG8_BAR; PG8_WAIT_L(0); PG8_MMA(0, 0, At, B0); PG8_BAR; PG8_SCHED;
            PG8_LDB(B1, 0, 1); PG8_STAGE(PG8_SB(0, 0), b2, voffB);
            PG8_BAR; PG8_WAIT_L(0); PG8_MMA(0, 1, At, B1); PG8_BAR;
            PG8_LDA(At, 0, 1); PG8_STAGE(PG8_SA(0, 0), a2, voffA);
            PG8_BAR; PG8_WAIT_L(0); PG8_MMA(1, 0, At, B0); PG8_BAR; PG8_SCHED;
            PG8_STAGE(PG8_SB(0, 1), b2 + hstep, voffB);
            PG8_WAIT_V(6); PG8_BAR; PG8_MMA(1, 1, At, B1); PG8_BAR;
            PG8_LDB(B0, 1, 0); PG8_SCHED; PG8_LDA(At, 1, 0); PG8_STAGE(PG8_SA(0, 1), a2 + hstep, voffA);
            PG8_WAIT_L(8); PG8_BAR; PG8_WAIT_L(0); PG8_MMA(0, 0, At, B0); PG8_BAR; PG8_SCHED;
            PG8_LDB(B1, 1, 1); PG8_STAGE(PG8_SB(1, 0), b3, voffB);
            PG8_BAR; PG8_WAIT_L(0); PG8_MMA(0, 1, At, B1); PG8_BAR;
            PG8_LDA(At, 1, 1); PG8_STAGE(PG8_SA(1, 0), a3, voffA);
            PG8_BAR; PG8_WAIT_L(0); PG8_MMA(1, 0, At, B0); PG8_BAR; PG8_SCHED;
            PG8_STAGE(PG8_SB(1, 1), b3 + hstep, voffB);
            PG8_WAIT_V(6); PG8_BAR; PG8_MMA(1, 1, At, B1); PG8_BAR;
            }
        }
        if constexpr (ALIGN_EPI) { if (wr == 0) PG8_BAR; }
        bool keep_acc = false;
        if constexpr (!Epi::AFTER_DRAIN) { if constexpr (Epi::DUAL) { if (cur.src == 0) { E.mid(acc, cur, wr, wc, fr, fq); keep_acc = true; } else E(acc, cur, wr, wc, fr, fq); } else E(acc, cur, wr, wc, fr, fq); S.done(cur); }
        if (!has_next) break;
        if (!keep_acc) {
#pragma unroll
        for (int a = 0; a < 2; ++a)
#pragma unroll
            for (int b = 0; b < 2; ++b)
#pragma unroll
                for (int m = 0; m < 4; ++m)
#pragma unroll
                    for (int n = 0; n < 2; ++n) acc[a][b][m][n] = (f32x4){0.f, 0.f, 0.f, 0.f};
        }
        cur = nxt; cA = nA; cB = nB; ++ui;
        if constexpr (ALIGN_EPI) { if (wr == 1) PG8_BAR; }
    }
    PG8_WAIT_V(0);
    if constexpr (!ALIGN_EPI) { if (wr == 0) PG8_BAR; }
    PG8_BAR;
    if constexpr (Epi::AFTER_DRAIN) { E.fused(acc, cur, wr, wc, fr, fq, lds, wid, lane); S.done(cur); }
#undef PG8_SA
#undef PG8_SB
#undef PG8_STAGE
#undef PG8_LDA
#undef PG8_LDB
#undef PG8_MMA
#undef PG8_WAIT_V
#undef PG8_WAIT_L
#undef PG8_BAR
#undef PG8_SCHED
}
}

#ifndef PG8_SP2
#define PG8_SP2 true
#endif
#ifndef PG8_ALIGN
#define PG8_ALIGN true
#endif
#include <hip/hip_bf16.h>
#include <cmath>
namespace attn_body {
using bf16=__hip_bfloat16;
using bf16x8=__attribute__((ext_vector_type(8)))short;
using s16x4=__attribute__((ext_vector_type(4)))short;
using f32x16=__attribute__((ext_vector_type(16)))float;
using u32x4=__attribute__((ext_vector_type(4)))unsigned;
constexpr int BATCH=16,NVH=16,SEQ=4096,D=64,DM=1024,OP=1024;
constexpr int NW=8,QBLK=32,QB=QBLK*NW,KVBLK=64,NQB=SEQ/QB;
constexpr int ATTN_PITCH=DM, ATTN_UNIT_ROWS=QB;
__device__ __forceinline__ int crow(int r,int hi){return (r&3)+8*(r>>2)+4*hi;}
#define SBAR() __builtin_amdgcn_sched_barrier(0)
__device__ __forceinline__ void cmask(f32x16&p0,f32x16&p1,int jb,int qrel,int hi){
  const float NEG=-INFINITY; int kb=64*jb+4*hi;
  #pragma unroll
  for(int r=0;r<16;++r){int kv=kb+(r&3)+8*(r>>2); if(kv>qrel)p0[r]=NEG; if(kv+32>qrel)p1[r]=NEG;}
}

constexpr int NSLOT=3, SLOTB=8192, SLOTV=16384;
constexpr int LDS_K=0, LDS_V=NSLOT*SLOTB, LDS_WS=LDS_V+NSLOT*SLOTV, LDS_OST=LDS_WS+NW*64*4, LDS_BYTES=LDS_OST+NW*4096;
constexpr float C2=0.125f*1.4426950408889634f;
__device__ __forceinline__ void glds16(const void*gsrc,unsigned lds_dst){unsigned keep;
  asm volatile("s_mov_b32 %0, m0\n\ts_mov_b32 m0, %2\n\ts_nop 0\n\tglobal_load_lds_dwordx4 %1, off\n\ts_mov_b32 m0, %0":"=&s"(keep):"v"(gsrc),"s"(lds_dst):"memory");}
__device__ __forceinline__ float max3f(float a,float b,float c){float r;asm("v_max3_f32 %0, %1, %2, %3":"=v"(r):"v"(a),"v"(b),"v"(c));return r;}
__device__ __forceinline__ float max2f(float a,float b){float r;asm("v_max_f32_e32 %0, %1, %2":"=v"(r):"v"(a),"v"(b));return r;}
__device__ __forceinline__ float fadd_s(float a,float b){float r;asm("v_add_f32_e32 %0, %1, %2":"=v"(r):"v"(a),"v"(b));return r;}
__device__ __forceinline__ float fsub_s(float a,float b){float r;asm("v_sub_f32_e32 %0, %1, %2":"=v"(r):"v"(a),"v"(b));return r;}
typedef float f32x2_t __attribute__((ext_vector_type(2))); typedef __bf16 bf16x2_t __attribute__((ext_vector_type(2)));
__device__ __forceinline__ unsigned cvtpk_s(float lo,float hi){f32x2_t v={lo,hi};bf16x2_t b=__builtin_convertvector(v,bf16x2_t);return __builtin_bit_cast(unsigned,b);}
#define WAIT_BAR(N) asm volatile("s_waitcnt vmcnt(" #N ") lgkmcnt(0)\n\ts_barrier":::"memory")

__device__ __forceinline__ void qkt(f32x16&p0,f32x16&p1,const char*Kslot,const bf16x8*qr,const f32x16&negm,int r32,int hi){
  const char*kb=Kslot+hi*1024+r32*16;
  #pragma unroll
  for(int d0=0;d0<4;++d0){
    const bf16x8 b0=*reinterpret_cast<const bf16x8*>(kb+d0*2048);
    const bf16x8 b1=*reinterpret_cast<const bf16x8*>(kb+d0*2048+512);
    if(d0==0){p0=__builtin_amdgcn_mfma_f32_32x32x16_bf16(b0,qr[0],negm,0,0,0);p1=__builtin_amdgcn_mfma_f32_32x32x16_bf16(b1,qr[0],negm,0,0,0);}
    else{p0=__builtin_amdgcn_mfma_f32_32x32x16_bf16(b0,qr[d0],p0,0,0,0);p1=__builtin_amdgcn_mfma_f32_32x32x16_bf16(b1,qr[d0],p1,0,0,0);}}
}
typedef __attribute__((address_space(3))) const char* lds_cptr;
typedef short v4i16_t __attribute__((ext_vector_type(4)));
__device__ __forceinline__ void kload8(bf16x8*kf,lds_cptr kp){
  kf[0]=*(const __attribute__((address_space(3))) bf16x8*)(kp);      kf[1]=*(const __attribute__((address_space(3))) bf16x8*)(kp+512);
  kf[2]=*(const __attribute__((address_space(3))) bf16x8*)(kp+2048); kf[3]=*(const __attribute__((address_space(3))) bf16x8*)(kp+2560);
  kf[4]=*(const __attribute__((address_space(3))) bf16x8*)(kp+4096); kf[5]=*(const __attribute__((address_space(3))) bf16x8*)(kp+4608);
  kf[6]=*(const __attribute__((address_space(3))) bf16x8*)(kp+6144); kf[7]=*(const __attribute__((address_space(3))) bf16x8*)(kp+6656);
}
__device__ __forceinline__ void kload2(bf16x8*kf,lds_cptr kp,int j){ kf[2*j]=*(const __attribute__((address_space(3))) bf16x8*)(kp+j*2048); kf[2*j+1]=*(const __attribute__((address_space(3))) bf16x8*)(kp+j*2048+512); }
__device__ __forceinline__ s16x4 vtr(lds_cptr p){ return __builtin_bit_cast(s16x4,__builtin_amdgcn_ds_read_tr16_b64_v4i16((__attribute__((address_space(3))) v4i16_t*)p)); }
__device__ __forceinline__ float rowmax(const f32x16&p0,const f32x16&p1){
  float a=max3f(p0[0],p0[1],p1[0]),b=max3f(p0[2],p0[3],p1[1]);a=max3f(a,p1[2],p1[3]);
  #pragma unroll
  for(int r=4;r<16;r+=4){a=max3f(a,p0[r],p0[r+1]);b=max3f(b,p0[r+2],p0[r+3]);a=max3f(a,p1[r],p1[r+1]);b=max3f(b,p1[r+2],p1[r+3]);}
  const float m=max2f(a,b);
  auto rr=__builtin_amdgcn_permlane32_swap(__float_as_uint(m),__float_as_uint(m),false,false);
  return max2f(__uint_as_float(rr[0]),__uint_as_float(rr[1]));
}
__device__ __forceinline__ void pv(f32x16*o,int vb,bf16x8 pa0,bf16x8 pa1,bf16x8 pa2,bf16x8 pa3){
  #pragma unroll
  for(int d0=0;d0<4;++d0){s16x4 lo[4],hi[4];
    #pragma unroll
    for(int ks=0;ks<4;++ks){
      asm volatile("ds_read_b64_tr_b16 %0,%1 offset:%c2":"=&v"(lo[ks]):"v"(vb),"i"(d0*4096+ks*1024):"memory");
      asm volatile("ds_read_b64_tr_b16 %0,%1 offset:%c2":"=&v"(hi[ks]):"v"(vb),"i"(d0*4096+ks*1024+512):"memory");}
    asm volatile("s_waitcnt lgkmcnt(0)":::"memory");SBAR();
    #define PK(k) (bf16x8){lo[k][0],lo[k][1],lo[k][2],lo[k][3],hi[k][0],hi[k][1],hi[k][2],hi[k][3]}
    o[d0]=__builtin_amdgcn_mfma_f32_32x32x16_bf16(pa0,PK(0),o[d0],0,0,0);
    o[d0]=__builtin_amdgcn_mfma_f32_32x32x16_bf16(pa1,PK(1),o[d0],0,0,0);
    o[d0]=__builtin_amdgcn_mfma_f32_32x32x16_bf16(pa2,PK(2),o[d0],0,0,0);
    o[d0]=__builtin_amdgcn_mfma_f32_32x32x16_bf16(pa3,PK(3),o[d0],0,0,0);
    #undef PK
  }
}

#ifndef ATTN_STORE16
#define ATTN_STORE16(p,v) (*(u32x4*)(p)=(v))
#endif
template<int THRL> __device__ __forceinline__ void attn_unit(int b,int qcol,int vcol,int ocol,int qb,const bf16*Q,const bf16*__restrict__ K,const bf16*__restrict__ V,bf16*O,char*shm){
  const int tid=threadIdx.x,lane=tid&63,r32=lane&31,hi=lane>>5; const int wid=__builtin_amdgcn_readfirstlane(tid>>6);
  const long rowbase=(long)b*SEQ; const int q0=qb*QB;
  const bf16*Qw=Q+(rowbase+q0+wid*QBLK)*DM+qcol;
  const bf16*Kh=K+rowbase*DM+qcol,*Vh=V+rowbase*DM+vcol;
  const unsigned lds0=(unsigned)(uintptr_t)shm;
  float*wsf=(float*)(shm+LDS_WS)+wid*64;
  const bf16*ksrc=Kh+(long)lane*DM+wid*8;
  const bf16*vsrc=Vh+(long)(16*(wid&3)+(lane>>2))*DM+(wid>>2)*32+(lane&3)*8;
  const unsigned kdst=lds0+LDS_K+wid*1024, vdst=lds0+LDS_V+wid*1024;
  #define DMA_K(t,slot) glds16(ksrc+(long)(t)*KVBLK*DM,(unsigned)__builtin_amdgcn_readfirstlane(kdst+(slot)))
  #define DMA_V(t,slot) do{ glds16(vsrc+(long)(t)*KVBLK*DM,(unsigned)__builtin_amdgcn_readfirstlane(vdst+2*(slot))); glds16(vsrc+(long)(t)*KVBLK*DM+64,(unsigned)__builtin_amdgcn_readfirstlane(vdst+2*(slot)+8192)); }while(0)
  const int vb0=(int)(lds0+LDS_V)+((lane>>4)&1)*32+(lane&3)*8+(4*hi+((lane&15)>>2))*64;
  const char*Kbase=shm+LDS_K; bf16x8 kf[8];
  const lds_cptr shm3=(lds_cptr)shm; const lds_cptr kp0=shm3+LDS_K+hi*1024+r32*16; const lds_cptr vp0=shm3+LDS_V+((lane>>4)&1)*32+(lane&3)*8+(4*hi+((lane&15)>>2))*64;
  const int NT=(q0+QB)/KVBLK;
  DMA_K(0,0);DMA_V(0,0);DMA_K(1,SLOTB);
  bf16x8 qr[4];
  { int lq=lane; asm volatile("":"+v"(lq)); const int r32q=lq&31,hiq=lq>>5;
  _Pragma("unroll") for(int d0=0;d0<4;++d0)qr[d0]=*reinterpret_cast<const bf16x8*>(&Qw[(long)r32q*DM+d0*16+hiq*8]); }
  float mhat=0.f,l_reg=0.f;f32x16 o[4],negm;
  { float z=0.f; asm volatile("":"+v"(z));
    _Pragma("unroll") for(int r=0;r<16;++r){o[0][r]=z;o[1][r]=z;o[2][r]=z;o[3][r]=z;negm[r]=z;} }
  asm volatile("":"+v"(negm));
  const int qrel=wid*QBLK+r32;
  #define CMASK(P0,P1,t) do{int jb_=(t)-(NT-4); if(jb_>=0)cmask(P0,P1,jb_,qrel,hi);}while(0)
  bool resc=false;
  #define START(P0,P1) do{ const float rm=rowmax(P0,P1); resc=false; \
    { const float dl=rm; mhat=fadd_s(mhat,dl); \
      _Pragma("unroll") for(int r=0;r<16;++r){P0[r]=fsub_s(P0[r],dl);P1[r]=fsub_s(P1[r],dl);} \
      _Pragma("unroll") for(int r=0;r<16;++r)negm[r]=-mhat; asm volatile("":"+v"(negm)); } \
    _Pragma("unroll") for(int r=0;r<16;++r)P0[r]=__builtin_amdgcn_exp2f(P0[r]); }while(0)
  #define RESC() do{ if(resc){ asm volatile("s_waitcnt lgkmcnt(0)":::"memory"); \
      _Pragma("unroll") for(int d_=0;d_<4;++d_) _Pragma("unroll") for(int r=0;r<16;++r)o[d_][r]*=wsf[crow(r,hi)]; } }while(0)
  f32x16 c0,c1;
  int sl_prev=0,sl_cur=0,sl_next=SLOTB;
  #define ROT() do{sl_prev=sl_cur;sl_cur=sl_next;sl_next=(sl_next==(NSLOT-1)*SLOTB)?0:sl_next+SLOTB;}while(0)
  DMA_K(2,2*SLOTB);
  WAIT_BAR(4);
  s16x4 vlo[8],vhi[8]; u32x4 pw0,pw1,pw2,pw3;
  #define PKW(P,B) cvtpk_s(P[B],P[B+1])
  #define PAF(k) __builtin_bit_cast(bf16x8,pw##k)
  #define VFR(i) (bf16x8){vlo[i][0],vlo[i][1],vlo[i][2],vlo[i][3],vhi[i][0],vhi[i][1],vhi[i][2],vhi[i][3]}
  #define PIN(x) asm volatile("":"+v"(x))
  qkt(c0,c1,Kbase,qr,negm,r32,hi);asm volatile("s_nop 15\n\ts_nop 7":"+v"(c0),"+v"(c1));CMASK(c0,c1,0);
  START(c0,c1);
  _Pragma("unroll") for(int r=0;r<16;++r)c1[r]=__builtin_amdgcn_exp2f(c1[r]);
  { float sacc=c0[0]+c0[1]; _Pragma("unroll") for(int r=2;r<16;++r)sacc+=c0[r]; _Pragma("unroll") for(int r=0;r<16;++r)sacc+=c1[r]; l_reg+=sacc;
    pw0=(u32x4){PKW(c0,0),PKW(c0,2),PKW(c0,4),PKW(c0,6)};pw1=(u32x4){PKW(c0,8),PKW(c0,10),PKW(c0,12),PKW(c0,14)};pw2=(u32x4){PKW(c1,0),PKW(c1,2),PKW(c1,4),PKW(c1,6)};pw3=(u32x4){PKW(c1,8),PKW(c1,10),PKW(c1,12),PKW(c1,14)}; }
  WAIT_BAR(0);
  DMA_K(3,0);DMA_V(1,SLOTB);
  ROT();
  kload8(kf,kp0+sl_cur);
  WAIT_BAR(3);
  #define MX3(a,b,c) __builtin_fmaxf(__builtin_fmaxf((a),(b)),(c))
  #define EX(v) __builtin_amdgcn_exp2f(v)
  #define GAPB(MF,X,B) do{ MF; X[B]=EX(X[B]); X[B+1]=EX(X[B+1]); X[B+2]=EX(X[B+2]); X[B+3]=EX(X[B+3]); PIN(X); SBAR(); }while(0)
  #define GAPC(MF,A0,A1,A2,A3) do{ MF; sacc+=A0; sacc+=A1; sacc+=A2; sacc+=A3; PIN(sacc); SBAR(); }while(0)
  #define VRD(i) do{ vlo[i]=vtr(vp_+(((i)>>2)*4096+((i)&3)*1024)); vhi[i]=vtr(vp_+(((i)>>2)*4096+((i)&3)*1024+512)); }while(0)
  #define VRD2(i) do{ vlo[i]=vtr(vp_+(8192+((i)>>2)*4096+((i)&3)*1024)); vhi[i]=vtr(vp_+(8192+((i)>>2)*4096+((i)&3)*1024+512)); SBAR(); }while(0)
  #define KRD(G,j) do{ if(G){ kload2(kf,kp0+sl_next,j); SBAR(); } }while(0)
  #define MF32(a,b,c) __builtin_amdgcn_mfma_f32_32x32x16_bf16(a,b,c,0,0,0)
  #define STEP(C0,C1,t,GK,GV,GL) do{ SBAR(); \
    const lds_cptr vp_=vp0+2*sl_prev; \
    VRD(0); SBAR(); C0=MF32(kf[0],qr[0],negm); SBAR(); \
    VRD(4); SBAR(); C1=MF32(kf[1],qr[0],negm); SBAR(); \
    VRD(1); SBAR(); C0=MF32(kf[2],qr[1],C0); SBAR(); \
    VRD(5); SBAR(); C1=MF32(kf[3],qr[1],C1); SBAR(); \
    VRD(2); SBAR(); C0=MF32(kf[4],qr[2],C0); SBAR(); \
    VRD(6); SBAR(); C1=MF32(kf[5],qr[2],C1); SBAR(); \
    VRD(3); SBAR(); C0=MF32(kf[6],qr[3],C0); SBAR(); \
    VRD(7); SBAR(); C1=MF32(kf[7],qr[3],C1); SBAR(); \
    if(GK){DMA_K((t)+3,sl_cur);} if(GV){DMA_V((t)+1,sl_next);} \
    CMASK(C0,C1,t); \
    { float a=MX3(C0[0],C0[1],C1[0]),b=MX3(C0[2],C0[3],C1[1]); a=MX3(a,C1[2],C1[3]); \
      _Pragma("unroll") for(int r=4;r<16;r+=4){a=MX3(a,C0[r],C0[r+1]);b=MX3(b,C0[r+2],C0[r+3]);a=MX3(a,C1[r],C1[r+1]);b=MX3(b,C1[r+2],C1[r+3]);} \
      float rm=__builtin_fmaxf(a,b); { auto rr=__builtin_amdgcn_permlane32_swap(__float_as_uint(rm),__float_as_uint(rm),false,false); rm=__builtin_fmaxf(__uint_as_float(rr[0]),__uint_as_float(rr[1])); } \
      resc=false; \
      if(__builtin_expect(__any(rm>(float)THRL),0)){ const float dl=__builtin_fmaxf(rm,0.f); mhat+=dl; \
        _Pragma("unroll") for(int r=0;r<16;++r){C0[r]-=dl;C1[r]-=dl;} \
        _Pragma("unroll") for(int r=0;r<16;++r)negm[r]=-mhat; asm volatile("":"+v"(negm)); \
        const float f=__builtin_amdgcn_exp2f(-dl); l_reg*=f; if(hi==0)wsf[r32]=f; resc=true; } } \
    SBAR(); \
    GAPB(o[0]=MF32(PAF(0),VFR(0),o[0]), C0,0);  VRD2(0); \
    GAPB(o[1]=MF32(PAF(0),VFR(4),o[1]), C0,4);  VRD2(4); \
    KRD(GL,0); GAPB(o[0]=MF32(PAF(1),VFR(1),o[0]), C0,8);  VRD2(1); \
    KRD(GL,1); GAPB(o[1]=MF32(PAF(1),VFR(5),o[1]), C0,12); VRD2(5); \
    KRD(GL,2); GAPB(o[0]=MF32(PAF(2),VFR(2),o[0]), C1,0);  VRD2(2); \
    KRD(GL,3); GAPB(o[1]=MF32(PAF(2),VFR(6),o[1]), C1,4);  VRD2(6); \
    GAPB(o[0]=MF32(PAF(3),VFR(3),o[0]), C1,8);  VRD2(3); \
    GAPB(o[1]=MF32(PAF(3),VFR(7),o[1]), C1,12); VRD2(7); \
    float sacc=0.f; \
    GAPC(o[2]=MF32(PAF(0),VFR(0),o[2]), C0[0],C0[1],C0[2],C0[3]); \
    GAPC(o[3]=MF32(PAF(0),VFR(4),o[3]), C0[4],C0[5],C0[6],C0[7]);     pw0=(u32x4){PKW(C0,0),PKW(C0,2),PKW(C0,4),PKW(C0,6)}; PIN(pw0); SBAR(); \
    GAPC(o[2]=MF32(PAF(1),VFR(1),o[2]), C0[8],C0[9],C0[10],C0[11]); \
    GAPC(o[3]=MF32(PAF(1),VFR(5),o[3]), C0[12],C0[13],C0[14],C0[15]); pw1=(u32x4){PKW(C0,8),PKW(C0,10),PKW(C0,12),PKW(C0,14)}; PIN(pw1); SBAR(); \
    GAPC(o[2]=MF32(PAF(2),VFR(2),o[2]), C1[0],C1[1],C1[2],C1[3]); \
    GAPC(o[3]=MF32(PAF(2),VFR(6),o[3]), C1[4],C1[5],C1[6],C1[7]);     pw2=(u32x4){PKW(C1,0),PKW(C1,2),PKW(C1,4),PKW(C1,6)}; PIN(pw2); SBAR(); \
    GAPC(o[2]=MF32(PAF(3),VFR(3),o[2]), C1[8],C1[9],C1[10],C1[11]); \
    GAPC(o[3]=MF32(PAF(3),VFR(7),o[3]), C1[12],C1[13],C1[14],C1[15]); pw3=(u32x4){PKW(C1,8),PKW(C1,10),PKW(C1,12),PKW(C1,14)}; PIN(pw3); SBAR(); \
    l_reg+=sacc; \
    }while(0)
  int t=1;
  #undef CMASK
  #define CMASK(P0,P1,t) do{}while(0)
  for(;t+5<NT;t+=2){
    STEP(c0,c1,t,true,true,true);     WAIT_BAR(3); RESC(); ROT();
    STEP(c0,c1,t+1,true,true,true);   WAIT_BAR(3); RESC(); ROT();
  }
  #undef CMASK
  #define CMASK(P0,P1,t) do{int jb_=(t)-(NT-4); if(jb_>=0)cmask(P0,P1,jb_,qrel,hi);}while(0)
  #define ENDW(tt) do{ if((tt)+3<NT){WAIT_BAR(3);} else if((tt)+2<NT){WAIT_BAR(2);} else {WAIT_BAR(0);} }while(0)
  for(;t+1<NT;t+=2){
    STEP(c0,c1,t,(t+3<NT),(t+1<NT),(t+1<NT));       ENDW(t);   RESC(); ROT();
    STEP(c0,c1,t+1,(t+4<NT),(t+2<NT),(t+2<NT));     ENDW(t+1); RESC(); ROT();
  }
  STEP(c0,c1,NT-1,false,false,false); RESC();
  SBAR(); pv(o,vb0+2*sl_cur,PAF(0),PAF(1),PAF(2),PAF(3));
  #undef PKW
  #undef PAF
  #undef VFR
  #undef PIN
  #undef MX3
  #undef GAPB
  #undef GAPC
  #undef EX
  #undef VRD
  #undef VRD2
  #undef KRD
  #undef MF32
  #undef STEP
  #undef ENDW
  {auto rr=__builtin_amdgcn_permlane32_swap(__float_as_uint(l_reg),__float_as_uint(l_reg),false,false);l_reg=__uint_as_float(rr[0])+__uint_as_float(rr[1]);}
  { int le=lane; asm volatile("":"+v"(le)); const int r32e=le&31,hie=le>>5;
  float*wse=(float*)(shm+LDS_WS)+wid*64;
  if(hie==0)wse[32+r32e]=l_reg;asm volatile("s_waitcnt lgkmcnt(0)":::"memory");
  float rli[16];
  #pragma unroll
  for(int r=0;r<16;++r)rli[r]=__builtin_amdgcn_rcpf(wse[32+crow(r,hie)]);
  bf16*Ow=O+(rowbase+q0+wid*QBLK)*OP+ocol;
  { bf16*stg=(bf16*)(shm+LDS_OST)+wid*2048;
    #pragma unroll
    for(int hf=0;hf<2;++hf){
      #pragma unroll
      for(int r=0;r<16;++r){const int orow=crow(r,hie);
        #pragma unroll
        for(int d0=0;d0<2;++d0)stg[orow*64+d0*32+r32e]=__float2bfloat16(o[2*hf+d0][r]*rli[r]);}
      asm volatile("s_waitcnt lgkmcnt(0)":::"memory");
      #pragma unroll
      for(int i=0;i<4;++i){const int row=i*8+(le>>3),ch=le&7; const u32x4 v=*(const u32x4*)(stg+row*64+ch*8); ATTN_STORE16(Ow+(long)row*OP+hf*64+ch*8,v);}
      asm volatile("s_waitcnt lgkmcnt(0)":::"memory"); } } }
  asm volatile("s_waitcnt lgkmcnt(0)\n\ts_barrier":::"memory");
  #undef DMA_K
  #undef DMA_V
  #undef CMASK
  #undef START
  #undef RESC
  #undef ROT
}
constexpr int ATTN_LDS_BYTES=LDS_BYTES;
struct AttnTensors { const bf16* Q; const bf16* K; const bf16* V; bf16* O; bf16* O2; };
struct AttnUnit { int bh; int qb; };
struct StaticOrder {
  int vcu,G;
  __device__ __forceinline__ explicit StaticOrder(int grid,int v):vcu(v),G(grid){}
  __device__ __forceinline__ bool next(int i,AttnUnit&u)const{ const int p=vcu+(i>>1)*G; if(p>=BATCH*NVH*8)return false; const int s=p&7; u.bh=p>>3; u.qb=(i&1)?15-s:s; return true; }
  __device__ __forceinline__ void a_ready(const AttnUnit&)const{}
  __device__ __forceinline__ void done(const AttnUnit&)const{}
};
template<class Sched,int THRL=8> __device__ __forceinline__ void attn_phase(char*lds,const AttnTensors&T,const Sched&S){
  AttnUnit u;
  for(int i=0;S.next(i,u);++i){ S.a_ready(u); { const int b_=u.bh>>4,hc_=u.bh&15,h_=hc_>>1,c_=hc_&1; attn_unit<THRL>(b_,h_*128+c_*64,h_*128,h_*128,u.qb,T.Q,T.K,T.V,c_?T.O2:T.O,lds); } S.done(u); }
}
#undef SBAR
#undef WAIT_BAR
}
namespace cg = cooperative_groups;
constexpr int NWAVES = 8;
#ifndef MK_N_LAUNCHES
#define MK_N_LAUNCHES 1
#endif
constexpr int N_PHASES = 8;
constexpr int N_LAUNCHES = MK_N_LAUNCHES;

constexpr int BATCH = 16, T = 4096, D = 1024, NCOLS = 10240;
constexpr int M = BATCH * T;
constexpr float NORM_EPS = 1e-6f, HEAD_EPS = 1e-5f, LAM_INIT = 0.2f;

constexpr size_t MiB = 1u << 20;
constexpr size_t WS_WIN = 2 * MiB, WS_WA = 22 * MiB, WS_WB = 24 * MiB, WS_WO = 26 * MiB;
constexpr size_t WS_XN = 32 * MiB, WS_SB = 160 * MiB, WS_CX = 288 * MiB, WS_Q = 416 * MiB, WS_K = 544 * MiB, WS_V = 672 * MiB, WS_ZB = 800 * MiB, WS_END = 928 * MiB;
constexpr size_t WS_AA = WS_XN;
constexpr size_t WS_O1 = WS_CX, WS_O2 = WS_SB;
constexpr size_t WS_AB = WS_ZB;
constexpr size_t WS_MM = WS_K;

constexpr int RING_OFF = 0, RING_BYTES = 131072;
constexpr int LDS_BYTES = 147456;

#define GAS __attribute__((address_space(1)))
#define LAS __attribute__((address_space(3)))
typedef unsigned short bf16;
typedef unsigned v4u __attribute__((ext_vector_type(4)));
typedef float f32x4 __attribute__((ext_vector_type(4)));
#define LDS_WAIT() asm volatile("s_waitcnt lgkmcnt(0)" ::: "memory")
__device__ __forceinline__ unsigned f2bf(float f) { unsigned u = __builtin_bit_cast(unsigned, f); return (u + 0x7fffu + ((u >> 16) & 1u)) >> 16; }
__device__ __forceinline__ unsigned pk2(float lo, float hi) { return f2bf(lo) | (f2bf(hi) << 16); }
__device__ __forceinline__ float blo(unsigned w) { return __builtin_bit_cast(float, w << 16); }
__device__ __forceinline__ float bhi(unsigned w) { return __builtin_bit_cast(float, w & 0xffff0000u); }

struct Frame {
    LAS unsigned char* lds;
    int tid, lane, wave, vcu, G;
};
__device__ __forceinline__ float wave_sum(float v) {
#pragma unroll
    for (int o = 1; o < 64; o <<= 1) v += __shfl_xor(v, o);
    return v;
}
__device__ __forceinline__ int win_dest_row(int n) {
    if (n >= 4096) return n;
    const int q = n >> 10, ch = n & 1023, pn = ch >> 6, c6 = ch & 63, wc = c6 >> 4, fq = (c6 >> 2) & 3, j = c6 & 3;
    return 256 * pn + 128 * (q >> 1) + 32 * wc + 8 * fq + 4 * (q & 1) + j;
}
template <bool PERMCONV>
__device__ __forceinline__ void p0_transpose_item(const float* W, int K, int N, bf16* WT, LAS float* scr, int item, int lane) {
    const int nblk = N / 32, kb = item / nblk, nb = item % nblk, k0 = 64 * kb, n0 = 32 * nb;
#pragma unroll 8
    for (int i = 0; i < 32; ++i) { const int kk = 2 * i + (lane >> 5); scr[kk * 33 + (lane & 31)] = W[(size_t)(k0 + kk) * N + n0 + (lane & 31)]; }
    LDS_WAIT(); asm volatile("" ::: "memory");
    const int c = lane & 7;
#pragma unroll
    for (int j = 0; j < 4; ++j) { const int n = (lane >> 3) + 8 * j; const LAS float* s = scr + (8 * c) * 33 + n;
        v4u o; o.x = pk2(s[0 * 33], s[1 * 33]); o.y = pk2(s[2 * 33], s[3 * 33]); o.z = pk2(s[4 * 33], s[5 * 33]); o.w = pk2(s[6 * 33], s[7 * 33]);
        const int dr = PERMCONV ? win_dest_row(n0 + n) : (n0 + n);
        *(GAS v4u*)(WT + (size_t)dr * K + k0 + 8 * c) = o; }
    LDS_WAIT(); asm volatile("" ::: "memory");
}
template <int NR>
__device__ __forceinline__ void rms_rows_to_bf16(int lane, const float* xrow, size_t rstride, const float* w, bf16* orow) {
    f32x4 v[NR][4]; float s2[NR];
#pragma unroll
    for (int r = 0; r < NR; ++r) { const GAS f32x4* xr = (const GAS f32x4*)(xrow + r * rstride) + lane;
#pragma unroll
        for (int j = 0; j < 4; ++j) v[r][j] = xr[64 * j]; }
    const GAS f32x4* wr = (const GAS f32x4*)w + lane; f32x4 ww[4];
#pragma unroll
    for (int j = 0; j < 4; ++j) ww[j] = wr[64 * j];
#pragma unroll
    for (int r = 0; r < NR; ++r) { s2[r] = 0.f;
#pragma unroll
        for (int j = 0; j < 4; ++j) s2[r] += (v[r][j].x * v[r][j].x + v[r][j].y * v[r][j].y) + (v[r][j].z * v[r][j].z + v[r][j].w * v[r][j].w); }
#pragma unroll
    for (int o = 1; o < 64; o <<= 1)
#pragma unroll
        for (int r = 0; r < NR; ++r) s2[r] += __shfl_xor(s2[r], o);
#pragma unroll
    for (int r = 0; r < NR; ++r) { const float rstd = 1.f / sqrtf(s2[r] * (1.f / D) + NORM_EPS);
        GAS unsigned long long* o8 = (GAS unsigned long long*)(orow + r * rstride) + lane;
#pragma unroll
        for (int j = 0; j < 4; ++j)
            o8[64 * j] = (unsigned long long)pk2(v[r][j].x * rstd * ww[j].x, v[r][j].y * rstd * ww[j].y) | ((unsigned long long)pk2(v[r][j].z * rstd * ww[j].z, v[r][j].w * rstd * ww[j].w) << 32); }
}
template <int NR>
__device__ __forceinline__ void rms_rows_f32(int lane, const float* xrow, size_t rstride, const float* w, float* orow) {
    f32x4 v[NR][4]; float s2[NR];
#pragma unroll
    for (int r = 0; r < NR; ++r) { const GAS f32x4* xr = (const GAS f32x4*)(xrow + r * rstride) + lane;
#pragma unroll
        for (int j = 0; j < 4; ++j) v[r][j] = xr[64 * j]; }
    const GAS f32x4* wr = (const GAS f32x4*)w + lane; f32x4 ww[4];
#pragma unroll
    for (int j = 0; j < 4; ++j) ww[j] = wr[64 * j];
#pragma unroll
    for (int r = 0; r < NR; ++r) { s2[r] = 0.f;
#pragma unroll
        for (int j = 0; j < 4; ++j) s2[r] += (v[r][j].x * v[r][j].x + v[r][j].y * v[r][j].y) + (v[r][j].z * v[r][j].z + v[r][j].w * v[r][j].w); }
#pragma unroll
    for (int o = 1; o < 64; o <<= 1)
#pragma unroll
        for (int r = 0; r < NR; ++r) s2[r] += __shfl_xor(s2[r], o);
#pragma unroll
    for (int r = 0; r < NR; ++r) { const float rstd = 1.f / sqrtf(s2[r] * (1.f / D) + NORM_EPS);
        GAS f32x4* o = (GAS f32x4*)(orow + r * rstride) + lane;
#pragma unroll
        for (int j = 0; j < 4; ++j) o[64 * j] = v[r][j] * rstd * ww[j]; }
}

struct Args { const float* in[14]; float* out; unsigned char* ws; int ph_lo, ph_hi; };
__device__ __forceinline__ int opq(int k) { asm volatile("" : "+s"(k)); return k; }
__device__ __forceinline__ size_t opq64(size_t k) { asm volatile("" : "+s"(k)); return k; }
__global__ void __launch_bounds__(NWAVES * 64, 2) hyb_fwd(Args args) {
    __builtin_assume(__builtin_amdgcn_workitem_id_y() == 0); __builtin_assume(__builtin_amdgcn_workitem_id_z() == 0);
    extern __shared__ __attribute__((aligned(16))) unsigned char lds[];
    Frame F;
    F.lds = (LAS unsigned char*)lds;
    F.tid = threadIdx.x; F.lane = F.tid & 63; F.wave = __builtin_amdgcn_readfirstlane(F.tid >> 6);
    F.G = gridDim.x; { const int bx = blockIdx.x; F.vcu = (F.G % 8 == 0) ? (bx % 8) * (F.G / 8) + bx / 8 : bx; }
#define KIN(k) (args.in[opq(k)])
#define WSP(off) ((bf16*)(args.ws + (size_t)opq64(off)))
    const int lo = args.ph_lo, hi = args.ph_hi;
#define IN(k) (lo <= (k) && (k) < hi)
#define SEAM(k) do { if (IN(k) && IN((k) + 1)) { cg::this_grid().sync(); } } while (0)
    const int gw = F.vcu * NWAVES + F.wave, NGW = F.G * NWAVES;

    if (IN(0)) {
        LAS float* scr = (LAS float*)(F.lds + RING_OFF + F.wave * 16384);
        const float* x = KIN(0); const float* norm_w = KIN(1); const float* w_in = KIN(2); const float* w_out_a = KIN(4); const float* w_out_b = KIN(10); const float* w_o = KIN(12);
        bf16* Win_t = WSP(WS_WIN); bf16* Wa_t = WSP(WS_WA); bf16* Wb_t = WSP(WS_WB); bf16* Wo_t = WSP(WS_WO); bf16* XN = WSP(WS_XN);
        constexpr int I_IN = (D / 64) * (NCOLS / 32), I_SQ = (D / 64) * (D / 32);
        constexpr int NITEMS = I_IN + 3 * I_SQ;
        for (int it = gw; it < NITEMS; it += NGW) {
            int r = it;
            if (r < I_IN) { p0_transpose_item<true>(w_in, D, NCOLS, Win_t, scr, r, F.lane); continue; } r -= I_IN;
            if (r < I_SQ) { p0_transpose_item<false>(w_out_a, D, D, Wa_t, scr, r, F.lane); continue; } r -= I_SQ;
            if (r < I_SQ) { p0_transpose_item<false>(w_out_b, D, D, Wb_t, scr, r, F.lane); continue; } r -= I_SQ;
            p0_transpose_item<false>(w_o, D, D, Wo_t, scr, r, F.lane);
        }
        for (int m = gw; m < M; m += 4 * NGW) rms_rows_to_bf16<4>(F.lane, x + (size_t)m * D, (size_t)NGW * D, norm_w, XN + (size_t)m * D);
    }
    SEAM(0);
    if (IN(1)) {
        bf16* XN = WSP(WS_XN); bf16* Win_t = WSP(WS_WIN); bf16* CX = WSP(WS_CX); bf16* SB = WSP(WS_SB); bf16* QB_ = WSP(WS_Q); bf16* GT = (bf16*)args.out; const float* b_gate = KIN(11);
        pg8::Gemm g{XN, Win_t, M, NCOLS, D}; pg8::StaticOrder S; S.init(M, NCOLS, F.G, (int)blockIdx.x);
        pg8::EpiInProj E{CX, SB, QB_, (size_t)(WS_K - WS_Q) / 2, GT, b_gate, attn_body::C2};
        pg8::gemm_phase<pg8::EpiInProj, pg8::StaticOrder, PG8_ALIGN, PG8_SP2>(F.lds + RING_OFF, g, S, E);
    }
    SEAM(1);
    if (IN(2)) {
        const int cgp = F.tid & 127, rs = F.tid >> 7, ch = cgp * 8;
        const float* conv_w = KIN(3); bf16* CX = WSP(WS_CX); bf16* SB = WSP(WS_SB); bf16* AA = WSP(WS_AA);
        float w0[8], w1[8], w2[8];
#pragma unroll
        for (int e = 0; e < 8; ++e) { w0[e] = conv_w[ch + e]; w1[e] = conv_w[1024 + ch + e]; w2[e] = conv_w[2048 + ch + e]; }
        for (int item = F.vcu; item < M / 64; item += F.G) {
            const int r0 = item * 64 + rs * 16;
            const bool first = (r0 % T) == 0;
            v4u p2 = (v4u){0u, 0u, 0u, 0u}, p1 = (v4u){0u, 0u, 0u, 0u};
            if (!first) { p2 = *(const GAS v4u*)(CX + (size_t)(r0 - 2) * 1024 + ch); p1 = *(const GAS v4u*)(CX + (size_t)(r0 - 1) * 1024 + ch); }
#pragma unroll
            for (int hb = 0; hb < 2; ++hb) {
                v4u c[8], s[8];
#pragma unroll
                for (int i = 0; i < 8; ++i) { c[i] = *(const GAS v4u*)(CX + (size_t)(r0 + hb * 8 + i) * 1024 + ch); s[i] = *(const GAS v4u*)(SB + (size_t)(r0 + hb * 8 + i) * 1024 + ch); }
#pragma unroll
                for (int i = 0; i < 8; ++i) {
                    const v4u cur = c[i]; v4u o;
#pragma unroll
                    for (int q = 0; q < 4; ++q) {
                        const float ylo = w0[2 * q] * blo(p2[q]) + w1[2 * q] * blo(p1[q]) + w2[2 * q] * blo(cur[q]);
                        const float yhi = w0[2 * q + 1] * bhi(p2[q]) + w1[2 * q + 1] * bhi(p1[q]) + w2[2 * q + 1] * bhi(cur[q]);
                        o[q] = pk2(ylo * blo(s[i][q]), yhi * bhi(s[i][q]));
                    }
                    *(GAS v4u*)(AA + (size_t)(r0 + hb * 8 + i) * 1024 + ch) = o;
                    p2 = p1; p1 = cur;
                }
            }
        }
    }
    SEAM(2);
    if (IN(3)) {
        bf16* QB_ = WSP(WS_Q); bf16* KB = WSP(WS_K); bf16* VB = WSP(WS_V); bf16* O1 = WSP(WS_O1); bf16* O2 = WSP(WS_O2);
        const attn_body::AttnTensors AT{(const attn_body::bf16*)QB_, (const attn_body::bf16*)KB, (const attn_body::bf16*)VB, (attn_body::bf16*)O1, (attn_body::bf16*)O2};
        const attn_body::StaticOrder S((int)F.G, F.vcu);
        attn_body::attn_phase<attn_body::StaticOrder>((char*)lds + RING_OFF, AT, S);
    }
    SEAM(3);
    if (IN(4)) {
        const float* lq1 = KIN(5); const float* lk1 = KIN(6); const float* lq2 = KIN(7); const float* lk2 = KIN(8); const float* head_w = KIN(9);
        bf16* O1 = WSP(WS_O1); bf16* O2 = WSP(WS_O2); bf16* ZB = WSP(WS_ZB); bf16* AB = WSP(WS_AB);
        const float d1 = lq1[F.lane] * lk1[F.lane], d2 = lq2[F.lane] * lk2[F.lane];
        const float lam = __expf(wave_sum(d1)) - __expf(wave_sum(d2)) + LAM_INIT;
        const int rsub = F.tid >> 7, l = F.tid & 127, h = l >> 4, j0 = (l & 15) * 8;
        float hw[8];
#pragma unroll
        for (int e = 0; e < 8; ++e) hw[e] = head_w[j0 + e] * (1.0f - LAM_INIT);
        for (int item = F.vcu; item < M / 32; item += F.G) {
#pragma unroll 2
            for (int ps = 0; ps < 8; ++ps) {
                const size_t row = (size_t)item * 32 + ps * 4 + rsub;
                const v4u o1 = *(const GAS v4u*)(O1 + row * 1024 + h * 128 + j0), o2 = *(const GAS v4u*)(O2 + row * 1024 + h * 128 + j0);
                const v4u z = *(const GAS v4u*)(ZB + row * 1024 + h * 128 + j0);
                float d[8]; float ss = 0.f;
#pragma unroll
                for (int q = 0; q < 4; ++q) { d[2 * q] = blo(o1[q]) - lam * blo(o2[q]); d[2 * q + 1] = bhi(o1[q]) - lam * bhi(o2[q]); ss += d[2 * q] * d[2 * q] + d[2 * q + 1] * d[2 * q + 1]; }
                ss += __shfl_xor(ss, 1); ss += __shfl_xor(ss, 2); ss += __shfl_xor(ss, 4); ss += __shfl_xor(ss, 8);
                const float rstd = 1.f / sqrtf(ss * (1.f / 128.f) + HEAD_EPS);
                v4u o;
#pragma unroll
                for (int q = 0; q < 4; ++q) o[q] = pk2(d[2 * q] * rstd * hw[2 * q] * pg8::silu_f(blo(z[q])), d[2 * q + 1] * rstd * hw[2 * q + 1] * pg8::silu_f(bhi(z[q])));
                *(GAS v4u*)(AB + row * 1024 + h * 128 + j0) = o;
            }
        }
    }
    SEAM(4);
    if (IN(5)) {
        bf16* AA = WSP(WS_AA); bf16* Wa_t = WSP(WS_WA); bf16* AB = WSP(WS_AB); bf16* Wb_t = WSP(WS_WB); bf16* MM = WSP(WS_MM); bf16* GT = (bf16*)args.out;
        pg8::Gemm g{AA, Wa_t, M, D, D, AB, Wb_t}; pg8::DualOrder S; S.init(M, D, F.G, (int)blockIdx.x);
        pg8::EpiDual E{MM, GT};
        pg8::gemm_phase<pg8::EpiDual, pg8::DualOrder, PG8_ALIGN, PG8_SP2>(F.lds + RING_OFF, g, S, E);
    }
    SEAM(5);
    if (IN(6)) {
        bf16* MM = WSP(WS_MM); bf16* Wo_t = WSP(WS_WO); float* out = args.out; const float* x = KIN(0);
        pg8::Gemm g{MM, Wo_t, M, D, D}; pg8::StaticOrder S; S.init(M, D, F.G, (int)blockIdx.x);
        pg8::EpiResF32 E{out, x};
        pg8::gemm_phase<pg8::EpiResF32, pg8::StaticOrder, PG8_ALIGN, PG8_SP2>(F.lds + RING_OFF, g, S, E);
    }
    SEAM(6);
    if (IN(7)) {
        float* out = args.out; const float* final_w = KIN(13);
        for (int m = gw; m < M; m += 4 * NGW) rms_rows_f32<4>(F.lane, out + (size_t)m * D, (size_t)NGW * D, final_w, out + (size_t)m * D);
    }
#undef IN
#undef SEAM
}

extern "C" void kernel_launch(void* const* d_in, const int* in_sizes, int n_in, void* d_out, int out_size, void* d_ws, size_t ws_size, hipStream_t stream) {
    static int grid = 0;
    if (grid == 0) {
        if (n_in != 14 || in_sizes[0] != M * D || out_size != M * D || ws_size < WS_END) { fprintf(stderr, "kernel_launch: unexpected shapes: n_in %d in0 %d out %d ws %zu\n", n_in, n_in > 0 ? in_sizes[0] : -1, out_size, ws_size); grid = -1; return; }
        int dev = 0, cus = 0, per_cu = 0;
        if (hipGetDevice(&dev) != hipSuccess || hipDeviceGetAttribute(&cus, hipDeviceAttributeMultiprocessorCount, dev) != hipSuccess) { grid = -1; return; }
        if (hipFuncSetAttribute((const void*)hyb_fwd, hipFuncAttributeMaxDynamicSharedMemorySize, LDS_BYTES) != hipSuccess) { fprintf(stderr, "kernel_launch: hipFuncSetAttribute failed\n"); grid = -1; return; }
        if (hipOccupancyMaxActiveBlocksPerMultiprocessor(&per_cu, (const void*)hyb_fwd, NWAVES * 64, LDS_BYTES) != hipSuccess || per_cu < 1) { fprintf(stderr, "kernel_launch: occupancy query says %d\n", per_cu); per_cu = 1; }
        (void)hipGetLastError();
        grid = cus;
    }
    if (grid < 0) return;
    Args a{};
    for (int i = 0; i < 14; ++i) a.in[i] = (const float*)d_in[i];
    a.out = (float*)d_out; a.ws = (unsigned char*)d_ws;
    if (N_LAUNCHES == 1) {
        a.ph_lo = 0; a.ph_hi = N_PHASES;
        void* kargs[] = {&a};
        const hipError_t e = hipLaunchCooperativeKernel((const void*)hyb_fwd, dim3(grid), dim3(NWAVES * 64), kargs, LDS_BYTES, stream);
        if (e != hipSuccess) fprintf(stderr, "kernel_launch: cooperative launch failed: %s (grid %d)\n", hipGetErrorString(e), grid);
    } else {
        for (int li = 0; li < N_PHASES; ++li) {
            a.ph_lo = li; a.ph_hi = li + 1;
            hipLaunchKernelGGL(hyb_fwd, dim3(grid), dim3(NWAVES * 64), LDS_BYTES, stream, a);
        }
    }
}
```

```cpp
#include <hip/hip_runtime.h>
#include <cstdio>
#include <cstdint>
#include <hip/hip_cooperative_groups.h>
namespace pg8 {
#define PG8_LAS __attribute__((address_space(3)))
typedef unsigned short bf16_t;
typedef short bf16x8 __attribute__((ext_vector_type(8)));
typedef float f32x4 __attribute__((ext_vector_type(4)));
typedef unsigned u32x4 __attribute__((ext_vector_type(4)));
constexpr int BM = 256, BK = 64, HALF = 128, HTB = HALF * BK * 2  , STAGE_BYTES = 8 * HTB, NXCD = 8, WGM = 8;

__host__ __device__ __forceinline__ int lds_byte(int r, int c) { const int st = (r >> 4) * 2 + (c >> 5), rr = r & 15, cc = c & 31, ob = rr * 64 + cc * 2; return st * 1024 + (ob ^ (((ob >> 9) & 1) << 5)); }
__host__ __device__ __forceinline__ void stage_rc(int b, int& R, int& C) { const int st = b / 1024, sb = b % 1024, swz = sb ^ (((sb >> 9) & 1) << 5); R = (st >> 1) * 16 + swz / 64; C = (st & 1) * 32 + (swz % 64) / 2; }
__host__ __device__ __forceinline__ int perm32(int rho) { const int n = rho >> 4, i = rho & 15; return 8 * (i >> 2) + 4 * n + (i & 3); }

struct Unit { int pm, pn, src; };
struct Gemm { const bf16_t* A; const bf16_t* Bt; int M, N, K; const bf16_t* A2; const bf16_t* Bt2; };

struct StaticOrder {
    int nM, nN, nwg, G, c;
    __host__ __device__ void init(int M, int N, int G_, int c_) { nM = M / BM; nN = N / BM; nwg = nM * nN; G = G_; c = c_; }
    __host__ __device__ bool next(int i, Unit& u) const {
        const long L = (long)i * G + c; if (L >= nwg) return false;
        int wgid = (int)L; { const int q = nwg / NXCD, r = nwg % NXCD, xcd = wgid % NXCD, off = wgid / NXCD; wgid = (xcd < r ? xcd * (q + 1) : r * (q + 1) + (xcd - r) * q) + off; }
        const int nig = WGM * nN, gid = wgid / nig, fm = gid * WGM, gsz = (nM - fm) < WGM ? (nM - fm) : WGM;
        u.pm = fm + ((wgid % nig) % gsz); u.pn = (wgid % nig) / gsz; u.src = 0; return true;
    }
    __device__ __forceinline__ void a_ready(const Unit&) const {}
    __device__ __forceinline__ void done(const Unit&) const {}
};

struct DualOrder {
    StaticOrder S0;
    __host__ __device__ void init(int M, int N, int G_, int c_) { S0.init(M, N, G_, c_); }
    __host__ __device__ bool next(int i, Unit& u) const { if (!S0.next(i >> 1, u)) return false; u.src = i & 1; return true; }
    __device__ __forceinline__ void a_ready(const Unit&) const {}
    __device__ __forceinline__ void done(const Unit&) const {}
};
typedef float cvt_f32x2_t __attribute__((ext_vector_type(2))); typedef __bf16 cvt_bf16x2_t __attribute__((ext_vector_type(2)));
__device__ __forceinline__ unsigned cvt_pk_bf16(float lo, float hi) { cvt_f32x2_t v = {lo, hi}; cvt_bf16x2_t b = __builtin_convertvector(v, cvt_bf16x2_t); return __builtin_bit_cast(unsigned, b); }
typedef float f32x2 __attribute__((ext_vector_type(2)));
__device__ __forceinline__ float sigmoid_f(float x) { return __builtin_amdgcn_rcpf(1.0f + __builtin_amdgcn_exp2f(-1.4426950408889634f * x)); }
__device__ __forceinline__ float silu_f(float x) { return x * sigmoid_f(x); }
__device__ __forceinline__ float bf_lo(unsigned w) { return __builtin_bit_cast(float, w << 16); }
__device__ __forceinline__ float bf_hi(unsigned w) { return __builtin_bit_cast(float, w & 0xffff0000u); }
typedef unsigned u32x2 __attribute__((ext_vector_type(2)));

struct EpiInProj {
    static constexpr bool PERM = true, AFTER_DRAIN = false, DUAL = false;
    bf16_t* CX; bf16_t* SB; bf16_t* QKVZ; size_t stride; bf16_t* GT; const float* bgate; float qscale;
    __device__ __forceinline__ void operator()(const f32x4 (&acc)[2][2][4][2], const Unit& u, int wr, int wc, int fr, int fq) const {
        const int row0 = u.pm * BM + wr * 64 + fr;
        if (u.pn < 16) {
            const int ch = u.pn * 64 + wc * 16 + fq * 4;
#pragma unroll
            for (int ai = 0; ai < 2; ++ai)
#pragma unroll
                for (int m = 0; m < 4; ++m) {
                    const size_t off = (size_t)(row0 + ai * HALF + m * 16) * 1024 + ch;
                    const f32x4 xa = acc[ai][0][m][0], cg = acc[ai][0][m][1], bg = acc[ai][1][m][0], za = acc[ai][1][m][1];
                    const f32x4 cx = xa * cg;
                    f32x4 sb; sb[0] = silu_f(za[0]) * bg[0]; sb[1] = silu_f(za[1]) * bg[1]; sb[2] = silu_f(za[2]) * bg[2]; sb[3] = silu_f(za[3]) * bg[3];
                    u32x2 w0, w1; w0.x = cvt_pk_bf16(cx[0], cx[1]); w0.y = cvt_pk_bf16(cx[2], cx[3]); w1.x = cvt_pk_bf16(sb[0], sb[1]); w1.y = cvt_pk_bf16(sb[2], sb[3]);
                    *(u32x2*)(CX + off) = w0; *(u32x2*)(SB + off) = w1;
                }
        } else if (u.pn < 32) {
            const int t = (u.pn - 16) >> 2; bf16_t* base = QKVZ + (size_t)t * stride; const float sc = (t == 0) ? qscale : 1.0f;
            const int col0 = ((u.pn - 16) & 3) * BM + wc * 32 + 8 * fq;
#pragma unroll
            for (int ai = 0; ai < 2; ++ai)
#pragma unroll
                for (int m = 0; m < 4; ++m) { bf16_t* rowp = base + (size_t)(row0 + ai * HALF + m * 16) * 1024 + col0;
#pragma unroll
                    for (int bj = 0; bj < 2; ++bj) { const f32x4 v0 = acc[ai][bj][m][0] * sc, v1 = acc[ai][bj][m][1] * sc;
                        u32x4 w; w.x = cvt_pk_bf16(v0[0], v0[1]); w.y = cvt_pk_bf16(v0[2], v0[3]); w.z = cvt_pk_bf16(v1[0], v1[1]); w.w = cvt_pk_bf16(v1[2], v1[3]);
                        *(u32x4*)(rowp + bj * HALF) = w; } }
        } else {
            const int col0 = (u.pn - 32) * BM + wc * 32 + 8 * fq;
            f32x4 bv[2][2];
#pragma unroll
            for (int bj = 0; bj < 2; ++bj)
#pragma unroll
                for (int n = 0; n < 2; ++n) bv[bj][n] = *(const f32x4*)(bgate + col0 + bj * HALF + 4 * n);
#pragma unroll
            for (int ai = 0; ai < 2; ++ai)
#pragma unroll
                for (int m = 0; m < 4; ++m) { bf16_t* rowp = GT + (size_t)(row0 + ai * HALF + m * 16) * 2048 + col0;
#pragma unroll
                    for (int bj = 0; bj < 2; ++bj) { const f32x4 a0 = acc[ai][bj][m][0] + bv[bj][0], a1 = acc[ai][bj][m][1] + bv[bj][1];
                        u32x4 w; w.x = cvt_pk_bf16(sigmoid_f(a0[0]), sigmoid_f(a0[1])); w.y = cvt_pk_bf16(sigmoid_f(a0[2]), sigmoid_f(a0[3]));
                        w.z = cvt_pk_bf16(sigmoid_f(a1[0]), sigmoid_f(a1[1])); w.w = cvt_pk_bf16(sigmoid_f(a1[2]), sigmoid_f(a1[3]));
                        *(u32x4*)(rowp + bj * HALF) = w; } }
        }
    }
};
struct EpiDual {
    static constexpr bool PERM = true, AFTER_DRAIN = false, DUAL = true;
    bf16_t* O; const bf16_t* G;
    __device__ __forceinline__ void mid(f32x4 (&acc)[2][2][4][2], const Unit& u, int wr, int wc, int fr, int fq) const {
        const int row0 = u.pm * BM + wr * 64 + fr, col0 = u.pn * BM + wc * 32 + 8 * fq;
#pragma unroll
        for (int ai = 0; ai < 2; ++ai)
#pragma unroll
            for (int mp = 0; mp < 2; ++mp) {
                u32x4 ga[2][2], gb[2][2];
#pragma unroll
                for (int mm = 0; mm < 2; ++mm)
#pragma unroll
                    for (int bj = 0; bj < 2; ++bj) { const bf16_t* gp = G + (size_t)(row0 + ai * HALF + (mp * 2 + mm) * 16) * 2048 + col0 + bj * HALF;
                        ga[mm][bj] = *(const u32x4*)gp; gb[mm][bj] = *(const u32x4*)(gp + 1024); }
#pragma unroll
                for (int mm = 0; mm < 2; ++mm)
#pragma unroll
                    for (int bj = 0; bj < 2; ++bj) { const u32x4 a = ga[mm][bj], b = gb[mm][bj]; const int m = mp * 2 + mm;
#define RT(x, y) ((x) * __builtin_amdgcn_rcpf(__builtin_fmaxf((y), 1e-20f)))
                        acc[ai][bj][m][0][0] *= RT(bf_lo(a.x), bf_lo(b.x)); acc[ai][bj][m][0][1] *= RT(bf_hi(a.x), bf_hi(b.x)); acc[ai][bj][m][0][2] *= RT(bf_lo(a.y), bf_lo(b.y)); acc[ai][bj][m][0][3] *= RT(bf_hi(a.y), bf_hi(b.y));
                        acc[ai][bj][m][1][0] *= RT(bf_lo(a.z), bf_lo(b.z)); acc[ai][bj][m][1][1] *= RT(bf_hi(a.z), bf_hi(b.z)); acc[ai][bj][m][1][2] *= RT(bf_lo(a.w), bf_lo(b.w)); acc[ai][bj][m][1][3] *= RT(bf_hi(a.w), bf_hi(b.w));
#undef RT
                    }
                asm volatile("" ::: "memory"); }
    }
    __device__ __forceinline__ void operator()(const f32x4 (&acc)[2][2][4][2], const Unit& u, int wr, int wc, int fr, int fq) const {
        const int row0 = u.pm * BM + wr * 64 + fr, col0 = u.pn * BM + wc * 32 + 8 * fq;
#pragma unroll
        for (int ai = 0; ai < 2; ++ai) {
            u32x4 g[4][2];
#pragma unroll
            for (int m = 0; m < 4; ++m)
#pragma unroll
                for (int bj = 0; bj < 2; ++bj) g[m][bj] = *(const u32x4*)(G + (size_t)(row0 + ai * HALF + m * 16) * 2048 + 1024 + col0 + bj * HALF);
#pragma unroll
            for (int m = 0; m < 4; ++m)
#pragma unroll
                for (int bj = 0; bj < 2; ++bj) { const size_t row = (size_t)(row0 + ai * HALF + m * 16); const int c = col0 + bj * HALF;
                    const u32x4 gv = g[m][bj]; const f32x4 a0 = acc[ai][bj][m][0], a1 = acc[ai][bj][m][1];
                    u32x4 w; w.x = cvt_pk_bf16(a0[0] * bf_lo(gv.x), a0[1] * bf_hi(gv.x)); w.y = cvt_pk_bf16(a0[2] * bf_lo(gv.y), a0[3] * bf_hi(gv.y));
                    w.z = cvt_pk_bf16(a1[0] * bf_lo(gv.z), a1[1] * bf_hi(gv.z)); w.w = cvt_pk_bf16(a1[2] * bf_lo(gv.w), a1[3] * bf_hi(gv.w));
                    *(u32x4*)(O + row * 1024 + c) = w; }
            asm volatile("" ::: "memory"); }
    }
};
struct EpiResF32 {
    static constexpr bool PERM = true, AFTER_DRAIN = false, DUAL = false;
    float* O; const float* X;
    __device__ __forceinline__ void operator()(const f32x4 (&acc)[2][2][4][2], const Unit& u, int wr, int wc, int fr, int fq) const {
        const int row0 = u.pm * BM + wr * 64 + fr, col0 = u.pn * BM + wc * 32 + 8 * fq;
#pragma unroll
        for (int ai = 0; ai < 2; ++ai)
#pragma unroll
            for (int mp = 0; mp < 2; ++mp) {
                f32x4 xv[2][2][2];
#pragma unroll
                for (int mm = 0; mm < 2; ++mm)
#pragma unroll
                    for (int bj = 0; bj < 2; ++bj)
#pragma unroll
                        for (int n = 0; n < 2; ++n) xv[mm][bj][n] = *(const f32x4*)(X + (size_t)(row0 + ai * HALF + (mp * 2 + mm) * 16) * 1024 + col0 + bj * HALF + 4 * n);
#pragma unroll
                for (int mm = 0; mm < 2; ++mm)
#pragma unroll
                    for (int bj = 0; bj < 2; ++bj)
#pragma unroll
                        for (int n = 0; n < 2; ++n) *(f32x4*)(O + (size_t)(row0 + ai * HALF + (mp * 2 + mm) * 16) * 1024 + col0 + bj * HALF + 4 * n) = xv[mm][bj][n] + acc[ai][bj][mp * 2 + mm][n];
                asm volatile("" ::: "memory"); }
    }
};

template <class Epi, class Sched, bool ALIGN_EPI = false, bool SP2 = false>
__device__ __forceinline__ void gemm_phase(PG8_LAS unsigned char* lds, const Gemm g, const Sched& S, const Epi& E) {
    const int tid = threadIdx.x, wid = __builtin_amdgcn_readfirstlane(tid >> 6), lane = tid & 63, wr = wid >> 2, wc = wid & 3, fr = lane & 15, fq = lane >> 4;
    const int K = g.K, nt = K / BK;
    unsigned voffA[2], voffB[2];
#pragma unroll
    for (int i = 0; i < 2; ++i) { int R, C; stage_rc(tid * 16 + i * 8192, R, C); const int Rb = Epi::PERM ? ((R & ~31) + perm32(R & 31)) : R;
        voffA[i] = (unsigned)(R * K + C) * 2u; voffB[i] = (unsigned)(Rb * K + C) * 2u; }
    const size_t kstep = (size_t)(BK * 2);
    const size_t hstep = (size_t)HALF * K * 2;
    const size_t tstep = 2 * hstep;
    const unsigned ldsw = (unsigned)wid * 1024u;
    const int aoff = lds_byte(wr * 64 + fr, fq * 8), boff = lds_byte(wc * 32 + fr, fq * 8);
#define PG8_SA(b, h) (((b) * 2 + (h)) * HTB)
#define PG8_SB(b, h) ((4 + (b) * 2 + (h)) * HTB)
#define PG8_STAGE(bufoff, gbase, voff) do { _Pragma("unroll") for (int _i = 0; _i < 2; ++_i) \
        __builtin_amdgcn_global_load_lds((const unsigned*)((const char*)(gbase) + (voff)[_i]), (PG8_LAS unsigned*)(lds + (bufoff) + ldsw + _i * 8192), 16, 0, 0); } while (0)
#define PG8_LDA(dst, b, h) do { _Pragma("unroll") for (int m = 0; m < 4; ++m) _Pragma("unroll") for (int k = 0; k < 2; ++k) dst[m][k] = *(const PG8_LAS bf16x8*)(lds + PG8_SA(b, h) + aoff + m * 2048 + k * 1024); } while (0)
#define PG8_LDB(dst, b, h) do { _Pragma("unroll") for (int n = 0; n < 2; ++n) _Pragma("unroll") for (int k = 0; k < 2; ++k) dst[n][k] = *(const PG8_LAS bf16x8*)(lds + PG8_SB(b, h) + boff + n * 2048 + k * 1024); } while (0)
#define PG8_MMA(ai, bj, At, Bt) do { __builtin_amdgcn_s_setprio(1); _Pragma("unroll") for (int m = 0; m < 4; ++m) _Pragma("unroll") for (int n = 0; n < 2; ++n) _Pragma("unroll") for (int k = 0; k < 2; ++k) \
        acc[ai][bj][m][n] = __builtin_amdgcn_mfma_f32_16x16x32_bf16(Bt[n][k], At[m][k], acc[ai][bj][m][n], 0, 0, 0); __builtin_amdgcn_s_setprio(0); } while (0)
#define PG8_WAIT_V(n) asm volatile("s_waitcnt vmcnt(" #n ")" ::: "memory")
#define PG8_WAIT_L(n) asm volatile("s_waitcnt lgkmcnt(" #n ")" ::: "memory")
#define PG8_BAR __builtin_amdgcn_s_barrier()
#define PG8_SCHED __builtin_amdgcn_sched_barrier(0)
    Unit cur, nxt; int ui = 0;
    if (!S.next(0, cur)) return;
    f32x4 acc[2][2][4][2];
#pragma unroll
    for (int a = 0; a < 2; ++a)
#pragma unroll
        for (int b = 0; b < 2; ++b)
#pragma unroll
            for (int m = 0; m < 4; ++m)
#pragma unroll
                for (int n = 0; n < 2; ++n) acc[a][b][m][n] = (f32x4){0.f, 0.f, 0.f, 0.f};
    bf16x8 At[4][2], B0[2][2], B1[2][2];
    const char* cA = (const char*)(cur.src ? g.A2 : g.A) + (size_t)cur.pm * tstep; const char* cB = (const char*)(cur.src ? g.Bt2 : g.Bt) + (size_t)cur.pn * tstep;
    S.a_ready(cur);
    if constexpr (SP2) {
        PG8_STAGE(PG8_SB(0, 0), cB, voffB); PG8_STAGE(PG8_SB(0, 1), cB + hstep, voffB); PG8_STAGE(PG8_SA(0, 0), cA, voffA); PG8_STAGE(PG8_SA(0, 1), cA + hstep, voffA);
        if (wr == 1) PG8_BAR;
        PG8_WAIT_V(2); PG8_BAR;
        PG8_STAGE(PG8_SB(1, 0), cB + kstep, voffB); PG8_STAGE(PG8_SA(1, 0), cA + kstep, voffA); PG8_STAGE(PG8_SB(1, 1), cB + hstep + kstep, voffB);
        PG8_WAIT_V(6); PG8_BAR;
    } else {
        PG8_STAGE(PG8_SB(0, 0), cB, voffB); PG8_STAGE(PG8_SA(0, 0), cA, voffA); PG8_STAGE(PG8_SB(0, 1), cB + hstep, voffB); PG8_STAGE(PG8_SA(0, 1), cA + hstep, voffA);
        if (wr == 1) PG8_BAR;
        PG8_WAIT_V(4); PG8_BAR;
        PG8_STAGE(PG8_SB(1, 0), cB + kstep, voffB); PG8_STAGE(PG8_SA(1, 0), cA + kstep, voffA); PG8_STAGE(PG8_SB(1, 1), cB + hstep + kstep, voffB);
        PG8_WAIT_V(6); PG8_BAR;
    }
    for (;;) {
        const bool has_next = S.next(ui + 1, nxt);
        const char* nA = has_next ? (const char*)(nxt.src ? g.A2 : g.A) + (size_t)nxt.pm * tstep : cA; const char* nB = has_next ? (const char*)(nxt.src ? g.Bt2 : g.Bt) + (size_t)nxt.pn * tstep : cB;
        for (int t = 0; t < nt; t += 2) {
            const bool last = (t == nt - 2);
            const char* a1 = cA + (size_t)(t + 1) * kstep;
            const char* a2 = last ? nA : cA + (size_t)(t + 2) * kstep; const char* b2 = last ? nB : cB + (size_t)(t + 2) * kstep;
            const char* a3 = a2 + kstep; const char* b3 = b2 + kstep;
            if (last && has_next) S.a_ready(nxt);
            if constexpr (SP2) {
            PG8_LDB(B0, 0, 0); PG8_LDB(B1, 0, 1); PG8_SCHED; PG8_LDA(At, 0, 0); PG8_STAGE(PG8_SA(1, 1), a1 + hstep, voffA);
            PG8_WAIT_V(8); PG8_WAIT_L(0); PG8_BAR; PG8_MMA(0, 0, At, B0); PG8_MMA(0, 1, At, B1); PG8_BAR; PG8_SCHED;
            PG8_LDA(At, 0, 1); PG8_STAGE(PG8_SB(0, 0), b2, voffB); PG8_STAGE(PG8_SB(0, 1), b2 + hstep, voffB); PG8_STAGE(PG8_SA(0, 0), a2, voffA);
            PG8_WAIT_V(8); PG8_WAIT_L(0); PG8_BAR; PG8_MMA(1, 0, At, B0); PG8_MMA(1, 1, At, B1); PG8_BAR; PG8_SCHED;
            PG8_LDB(B0, 1, 0); PG8_LDB(B1, 1, 1); PG8_SCHED; PG8_LDA(At, 1, 0); PG8_STAGE(PG8_SA(0, 1), a2 + hstep, voffA);
            PG8_WAIT_V(8); PG8_WAIT_L(0); PG8_BAR; PG8_MMA(0, 0, At, B0); PG8_MMA(0, 1, At, B1); PG8_BAR; PG8_SCHED;
            PG8_LDA(At, 1, 1); PG8_STAGE(PG8_SB(1, 0), b3, voffB); PG8_STAGE(PG8_SB(1, 1), b3 + hstep, voffB); PG8_STAGE(PG8_SA(1, 0), a3, voffA);
            PG8_WAIT_V(8); PG8_WAIT_L(0); PG8_BAR; PG8_MMA(1, 0, At, B0); PG8_MMA(1, 1, At, B1); PG8_BAR; PG8_SCHED;
            } else {
            PG8_LDB(B0, 0, 0); PG8_SCHED; PG8_LDA(At, 0, 0); PG8_STAGE(PG8_SA(1, 1), a1 + hstep, voffA);
            PG8_WAIT_L(8); PG8_BAR; PG8_WAIT_L(0); PG8_MMA(0, 0, At, B0); PG8_BAR; PG8_SCHED;
            PG8_LDB(B1, 0, 1); PG8_STAGE(PG8_SB(0, 0), b2, voffB);
            PG8_BAR; PG8_WAIT_L(0); PG8_MMA(0, 1, At, B1); PG8_BAR;
            PG8_LDA(At, 0, 1); PG8_STAGE(PG8_SA(0, 0), a2, voffA);
            PG8_BAR; PG8_WAIT_L(0); PG8_MMA(1, 0, At, B0); PG8_BAR; PG8_SCHED;
            PG8_STAGE(PG8_SB(0, 1), b2 + hstep, voffB);
            PG8_WAIT_V(6); PG8_BAR; PG8_MMA(1, 1, At, B1); PG8_BAR;
            PG8_LDB(B0, 1, 0); PG8_SCHED; PG8_LDA(At, 1, 0); PG8_STAGE(PG8_SA(0, 1), a2 + hstep, voffA);
            PG8_WAIT_L(8); PG8_BAR; PG8_WAIT_L(0); PG8_MMA(0, 0, At, B0); PG8_BAR; PG8_SCHED;
            PG8_LDB(B1, 1, 1); PG8_STAGE(PG8_SB(1, 0), b3, voffB);
            PG8_BAR; PG8_WAIT_L(0); PG8_MMA(0, 1, At, B1); PG8_BAR;
            PG8_LDA(At, 1, 1); PG8_STAGE(PG8_SA(1, 0), a3, voffA);
            PG8_BAR; PG8_WAIT_L(0); PG8_MMA(1, 0, At, B0); PG8_BAR; PG8_SCHED;
            PG8_STAGE(PG8_SB(1, 1), b3 + hstep, voffB);
            PG8_WAIT_V(6); PG8_BAR; PG8_MMA(1, 1, At, B1); PG8_BAR;
            }
        }
        if constexpr (ALIGN_EPI) { if (wr == 0) PG8_BAR; }
        bool keep_acc = false;
        if constexpr (!Epi::AFTER_DRAIN) { if constexpr (Epi::DUAL) { if (cur.src == 0) { E.mid(acc, cur, wr, wc, fr, fq); keep_acc = true; } else E(acc, cur, wr, wc, fr, fq); } else E(acc, cur, wr, wc, fr, fq); S.done(cur); }
        if (!has_next) break;
        if (!keep_acc) {
#pragma unroll
        for (int a = 0; a < 2; ++a)
#pragma unroll
            for (int b = 0; b < 2; ++b)
#pragma unroll
                for (int m = 0; m < 4; ++m)
#pragma unroll
                    for (int n = 0; n < 2; ++n) acc[a][b][m][n] = (f32x4){0.f, 0.f, 0.f, 0.f};
        }
        cur = nxt; cA = nA; cB = nB; ++ui;
        if constexpr (ALIGN_EPI) { if (wr == 1) PG8_BAR; }
    }
    PG8_WAIT_V(0);
    if constexpr (!ALIGN_EPI) { if (wr == 0) PG8_BAR; }
    PG8_BAR;
    if constexpr (Epi::AFTER_DRAIN) { E.fused(acc, cur, wr, wc, fr, fq, lds, wid, lane); S.done(cur); }
#undef PG8_SA
#undef PG8_SB
#undef PG8_STAGE
#undef PG8_LDA
#undef PG8_LDB
#undef PG8_MMA
#undef PG8_WAIT_V
#undef PG8_WAIT_L
#undef PG8_BAR
#undef PG8_SCHED
}
}

#ifndef PG8_SP2
#define PG8_SP2 true
#endif
#ifndef PG8_ALIGN
#define PG8_ALIGN true
#endif
#include <hip/hip_bf16.h>
#include <cmath>
namespace attn_body {
using bf16=__hip_bfloat16;
using bf16x8=__attribute__((ext_vector_type(8)))short;
using s16x4=__attribute__((ext_vector_type(4)))short;
using f32x16=__attribute__((ext_vector_type(16)))float;
using u32x4=__attribute__((ext_vector_type(4)))unsigned;
constexpr int BATCH=16,NVH=16,SEQ=4096,D=64,DM=1024,OP=1024;
constexpr int NW=8,QBLK=32,QB=QBLK*NW,KVBLK=64,NQB=SEQ/QB;
constexpr int ATTN_PITCH=DM, ATTN_UNIT_ROWS=QB;
__device__ __forceinline__ int crow(int r,int hi){return (r&3)+8*(r>>2)+4*hi;}
#define SBAR() __builtin_amdgcn_sched_barrier(0)
__device__ __forceinline__ void cmask(f32x16&p0,f32x16&p1,int jb,int qrel,int hi){
  const float NEG=-INFINITY; int kb=64*jb+4*hi;
  #pragma unroll
  for(int r=0;r<16;++r){int kv=kb+(r&3)+8*(r>>2); if(kv>qrel)p0[r]=NEG; if(kv+32>qrel)p1[r]=NEG;}
}

constexpr int NSLOT=3, SLOTB=8192, SLOTV=16384;
constexpr int LDS_K=0, LDS_V=NSLOT*SLOTB, LDS_WS=LDS_V+NSLOT*SLOTV, LDS_OST=LDS_WS+NW*64*4, LDS_BYTES=LDS_OST+NW*4096;
constexpr float C2=0.125f*1.4426950408889634f;
__device__ __forceinline__ void glds16(const void*gsrc,unsigned lds_dst){unsigned keep;
  asm volatile("s_mov_b32 %0, m0\n\ts_mov_b32 m0, %2\n\ts_nop 0\n\tglobal_load_lds_dwordx4 %1, off\n\ts_mov_b32 m0, %0":"=&s"(keep):"v"(gsrc),"s"(lds_dst):"memory");}
__device__ __forceinline__ float max3f(float a,float b,float c){float r;asm("v_max3_f32 %0, %1, %2, %3":"=v"(r):"v"(a),"v"(b),"v"(c));return r;}
__device__ __forceinline__ float max2f(float a,float b){float r;asm("v_max_f32_e32 %0, %1, %2":"=v"(r):"v"(a),"v"(b));return r;}
__device__ __forceinline__ float fadd_s(float a,float b){float r;asm("v_add_f32_e32 %0, %1, %2":"=v"(r):"v"(a),"v"(b));return r;}
__device__ __forceinline__ float fsub_s(float a,float b){float r;asm("v_sub_f32_e32 %0, %1, %2":"=v"(r):"v"(a),"v"(b));return r;}
typedef float f32x2_t __attribute__((ext_vector_type(2))); typedef __bf16 bf16x2_t __attribute__((ext_vector_type(2)));
__device__ __forceinline__ unsigned cvtpk_s(float lo,float hi){f32x2_t v={lo,hi};bf16x2_t b=__builtin_convertvector(v,bf16x2_t);return __builtin_bit_cast(unsigned,b);}
#define WAIT_BAR(N) asm volatile("s_waitcnt vmcnt(" #N ") lgkmcnt(0)\n\ts_barrier":::"memory")

__device__ __forceinline__ void qkt(f32x16&p0,f32x16&p1,const char*Kslot,const bf16x8*qr,const f32x16&negm,int r32,int hi){
  const char*kb=Kslot+hi*1024+r32*16;
  #pragma unroll
  for(int d0=0;d0<4;++d0){
    const bf16x8 b0=*reinterpret_cast<const bf16x8*>(kb+d0*2048);
    const bf16x8 b1=*reinterpret_cast<const bf16x8*>(kb+d0*2048+512);
    if(d0==0){p0=__builtin_amdgcn_mfma_f32_32x32x16_bf16(b0,qr[0],negm,0,0,0);p1=__builtin_amdgcn_mfma_f32_32x32x16_bf16(b1,qr[0],negm,0,0,0);}
    else{p0=__builtin_amdgcn_mfma_f32_32x32x16_bf16(b0,qr[d0],p0,0,0,0);p1=__builtin_amdgcn_mfma_f32_32x32x16_bf16(b1,qr[d0],p1,0,0,0);}}
}
typedef __attribute__((address_space(3))) const char* lds_cptr;
typedef short v4i16_t __attribute__((ext_vector_type(4)));
__device__ __forceinline__ void kload8(bf16x8*kf,lds_cptr kp){
  kf[0]=*(const __attribute__((address_space(3))) bf16x8*)(kp);      kf[1]=*(const __attribute__((address_space(3))) bf16x8*)(kp+512);
  kf[2]=*(const __attribute__((address_space(3))) bf16x8*)(kp+2048); kf[3]=*(const __attribute__((address_space(3))) bf16x8*)(kp+2560);
  kf[4]=*(const __attribute__((address_space(3))) bf16x8*)(kp+4096); kf[5]=*(const __attribute__((address_space(3))) bf16x8*)(kp+4608);
  kf[6]=*(const __attribute__((address_space(3))) bf16x8*)(kp+6144); kf[7]=*(const __attribute__((address_space(3))) bf16x8*)(kp+6656);
}
__device__ __forceinline__ void kload2(bf16x8*kf,lds_cptr kp,int j){ kf[2*j]=*(const __attribute__((address_space(3))) bf16x8*)(kp+j*2048); kf[2*j+1]=*(const __attribute__((address_space(3))) bf16x8*)(kp+j*2048+512); }
__device__ __forceinline__ s16x4 vtr(lds_cptr p){ return __builtin_bit_cast(s16x4,__builtin_amdgcn_ds_read_tr16_b64_v4i16((__attribute__((address_space(3))) v4i16_t*)p)); }
__device__ __forceinline__ float rowmax(const f32x16&p0,const f32x16&p1){
  float a=max3f(p0[0],p0[1],p1[0]),b=max3f(p0[2],p0[3],p1[1]);a=max3f(a,p1[2],p1[3]);
  #pragma unroll
  for(int r=4;r<16;r+=4){a=max3f(a,p0[r],p0[r+1]);b=max3f(b,p0[r+2],p0[r+3]);a=max3f(a,p1[r],p1[r+1]);b=max3f(b,p1[r+2],p1[r+3]);}
  const float m=max2f(a,b);
  auto rr=__builtin_amdgcn_permlane32_swap(__float_as_uint(m),__float_as_uint(m),false,false);
  return max2f(__uint_as_float(rr[0]),__uint_as_float(rr[1]));
}
__device__ __forceinline__ void pv(f32x16*o,int vb,bf16x8 pa0,bf16x8 pa1,bf16x8 pa2,bf16x8 pa3){
  #pragma unroll
  for(int d0=0;d0<4;++d0){s16x4 lo[4],hi[4];
    #pragma unroll
    for(int ks=0;ks<4;++ks){
      asm volatile("ds_read_b64_tr_b16 %0,%1 offset:%c2":"=&v"(lo[ks]):"v"(vb),"i"(d0*4096+ks*1024):"memory");
      asm volatile("ds_read_b64_tr_b16 %0,%1 offset:%c2":"=&v"(hi[ks]):"v"(vb),"i"(d0*4096+ks*1024+512):"memory");}
    asm volatile("s_waitcnt lgkmcnt(0)":::"memory");SBAR();
    #define PK(k) (bf16x8){lo[k][0],lo[k][1],lo[k][2],lo[k][3],hi[k][0],hi[k][1],hi[k][2],hi[k][3]}
    o[d0]=__builtin_amdgcn_mfma_f32_32x32x16_bf16(pa0,PK(0),o[d0],0,0,0);
    o[d0]=__builtin_amdgcn_mfma_f32_32x32x16_bf16(pa1,PK(1),o[d0],0,0,0);
    o[d0]=__builtin_amdgcn_mfma_f32_32x32x16_bf16(pa2,PK(2),o[d0],0,0,0);
    o[d0]=__builtin_amdgcn_mfma_f32_32x32x16_bf16(pa3,PK(3),o[d0],0,0,0);
    #undef PK
  }
}

#ifndef ATTN_STORE16
#define ATTN_STORE16(p,v) (*(u32x4*)(p)=(v))
#endif
template<int THRL> __device__ __forceinline__ void attn_unit(int b,int qcol,int vcol,int ocol,int qb,const bf16*Q,const bf16*__restrict__ K,const bf16*__restrict__ V,bf16*O,char*shm){
  const int tid=threadIdx.x,lane=tid&63,r32=lane&31,hi=lane>>5; const int wid=__builtin_amdgcn_readfirstlane(tid>>6);
  const long rowbase=(long)b*SEQ; const int q0=qb*QB;
  const bf16*Qw=Q+(rowbase+q0+wid*QBLK)*DM+qcol;
  const bf16*Kh=K+rowbase*DM+qcol,*Vh=V+rowbase*DM+vcol;
  const unsigned lds0=(unsigned)(uintptr_t)shm;
  float*wsf=(float*)(shm+LDS_WS)+wid*64;
  const bf16*ksrc=Kh+(long)lane*DM+wid*8;
  const bf16*vsrc=Vh+(long)(16*(wid&3)+(lane>>2))*DM+(wid>>2)*32+(lane&3)*8;
  const unsigned kdst=lds0+LDS_K+wid*1024, vdst=lds0+LDS_V+wid*1024;
  #define DMA_K(t,slot) glds16(ksrc+(long)(t)*KVBLK*DM,(unsigned)__builtin_amdgcn_readfirstlane(kdst+(slot)))
  #define DMA_V(t,slot) do{ glds16(vsrc+(long)(t)*KVBLK*DM,(unsigned)__builtin_amdgcn_readfirstlane(vdst+2*(slot))); glds16(vsrc+(long)(t)*KVBLK*DM+64,(unsigned)__builtin_amdgcn_readfirstlane(vdst+2*(slot)+8192)); }while(0)
  const int vb0=(int)(lds0+LDS_V)+((lane>>4)&1)*32+(lane&3)*8+(4*hi+((lane&15)>>2))*64;
  const char*Kbase=shm+LDS_K; bf16x8 kf[8];
  const lds_cptr shm3=(lds_cptr)shm; const lds_cptr kp0=shm3+LDS_K+hi*1024+r32*16; const lds_cptr vp0=shm3+LDS_V+((lane>>4)&1)*32+(lane&3)*8+(4*hi+((lane&15)>>2))*64;
  const int NT=(q0+QB)/KVBLK;
  DMA_K(0,0);DMA_V(0,0);DMA_K(1,SLOTB);
  bf16x8 qr[4];
  { int lq=lane; asm volatile("":"+v"(lq)); const int r32q=lq&31,hiq=lq>>5;
  _Pragma("unroll") for(int d0=0;d0<4;++d0)qr[d0]=*reinterpret_cast<const bf16x8*>(&Qw[(long)r32q*DM+d0*16+hiq*8]); }
  float mhat=0.f,l_reg=0.f;f32x16 o[4],negm;
  { float z=0.f; asm volatile("":"+v"(z));
    _Pragma("unroll") for(int r=0;r<16;++r){o[0][r]=z;o[1][r]=z;o[2][r]=z;o[3][r]=z;negm[r]=z;} }
  asm volatile("":"+v"(negm));
  const int qrel=wid*QBLK+r32;
  #define CMASK(P0,P1,t) do{int jb_=(t)-(NT-4); if(jb_>=0)cmask(P0,P1,jb_,qrel,hi);}while(0)
  bool resc=false;
  #define START(P0,P1) do{ const float rm=rowmax(P0,P1); resc=false; \
    { const float dl=rm; mhat=fadd_s(mhat,dl); \
      _Pragma("unroll") for(int r=0;r<16;++r){P0[r]=fsub_s(P0[r],dl);P1[r]=fsub_s(P1[r],dl);} \
      _Pragma("unroll") for(int r=0;r<16;++r)negm[r]=-mhat; asm volatile("":"+v"(negm)); } \
    _Pragma("unroll") for(int r=0;r<16;++r)P0[r]=__builtin_amdgcn_exp2f(P0[r]); }while(0)
  #define RESC() do{ if(resc){ asm volatile("s_waitcnt lgkmcnt(0)":::"memory"); \
      _Pragma("unroll") for(int d_=0;d_<4;++d_) _Pragma("unroll") for(int r=0;r<16;++r)o[d_][r]*=wsf[crow(r,hi)]; } }while(0)
  f32x16 c0,c1;
  int sl_prev=0,sl_cur=0,sl_next=SLOTB;
  #define ROT() do{sl_prev=sl_cur;sl_cur=sl_next;sl_next=(sl_next==(NSLOT-1)*SLOTB)?0:sl_next+SLOTB;}while(0)
  DMA_K(2,2*SLOTB);
  WAIT_BAR(4);
  s16x4 vlo[8],vhi[8]; u32x4 pw0,pw1,pw2,pw3;
  #define PKW(P,B) cvtpk_s(P[B],P[B+1])
  #define PAF(k) __builtin_bit_cast(bf16x8,pw##k)
  #define VFR(i) (bf16x8){vlo[i][0],vlo[i][1],vlo[i][2],vlo[i][3],vhi[i][0],vhi[i][1],vhi[i][2],vhi[i][3]}
  #define PIN(x) asm volatile("":"+v"(x))
  qkt(c0,c1,Kbase,qr,negm,r32,hi);asm volatile("s_nop 15\n\ts_nop 7":"+v"(c0),"+v"(c1));CMASK(c0,c1,0);
  START(c0,c1);
  _Pragma("unroll") for(int r=0;r<16;++r)c1[r]=__builtin_amdgcn_exp2f(c1[r]);
  { float sacc=c0[0]+c0[1]; _Pragma("unroll") for(int r=2;r<16;++r)sacc+=c0[r]; _Pragma("unroll") for(int r=0;r<16;++r)sacc+=c1[r]; l_reg+=sacc;
    pw0=(u32x4){PKW(c0,0),PKW(c0,2),PKW(c0,4),PKW(c0,6)};pw1=(u32x4){PKW(c0,8),PKW(c0,10),PKW(c0,12),PKW(c0,14)};pw2=(u32x4){PKW(c1,0),PKW(c1,2),PKW(c1,4),PKW(c1,6)};pw3=(u32x4){PKW(c1,8),PKW(c1,10),PKW(c1,12),PKW(c1,14)}; }
  WAIT_BAR(0);
  DMA_K(3,0);DMA_V(1,SLOTB);
  ROT();
  kload8(kf,kp0+sl_cur);
  WAIT_BAR(3);
  #define MX3(a,b,c) __builtin_fmaxf(__builtin_fmaxf((a),(b)),(c))
  #define EX(v) __builtin_amdgcn_exp2f(v)
  #define GAPB(MF,X,B) do{ MF; X[B]=EX(X[B]); X[B+1]=EX(X[B+1]); X[B+2]=EX(X[B+2]); X[B+3]=EX(X[B+3]); PIN(X); SBAR(); }while(0)
  #define GAPC(MF,A0,A1,A2,A3) do{ MF; sacc+=A0; sacc+=A1; sacc+=A2; sacc+=A3; PIN(sacc); SBAR(); }while(0)
  #define VRD(i) do{ vlo[i]=vtr(vp_+(((i)>>2)*4096+((i)&3)*1024)); vhi[i]=vtr(vp_+(((i)>>2)*4096+((i)&3)*1024+512)); }while(0)
  #define VRD2(i) do{ vlo[i]=vtr(vp_+(8192+((i)>>2)*4096+((i)&3)*1024)); vhi[i]=vtr(vp_+(8192+((i)>>2)*4096+((i)&3)*1024+512)); SBAR(); }while(0)
  #define KRD(G,j) do{ if(G){ kload2(kf,kp0+sl_next,j); SBAR(); } }while(0)
  #define MF32(a,b,c) __builtin_amdgcn_mfma_f32_32x32x16_bf16(a,b,c,0,0,0)
  #define STEP(C0,C1,t,GK,GV,GL) do{ SBAR(); \
    const lds_cptr vp_=vp0+2*sl_prev; \
    VRD(0); SBAR(); C0=MF32(kf[0],qr[0],negm); SBAR(); \
    VRD(4); SBAR(); C1=MF32(kf[1],qr[0],negm); SBAR(); \
    VRD(1); SBAR(); C0=MF32(kf[2],qr[1],C0); SBAR(); \
    VRD(5); SBAR(); C1=MF32(kf[3],qr[1],C1); SBAR(); \
    VRD(2); SBAR(); C0=MF32(kf[4],qr[2],C0); SBAR(); \
    VRD(6); SBAR(); C1=MF32(kf[5],qr[2],C1); SBAR(); \
    VRD(3); SBAR(); C0=MF32(kf[6],qr[3],C0); SBAR(); \
    VRD(7); SBAR(); C1=MF32(kf[7],qr[3],C1); SBAR(); \
    if(GK){DMA_K((t)+3,sl_cur);} if(GV){DMA_V((t)+1,sl_next);} \
    CMASK(C0,C1,t); \
    { float a=MX3(C0[0],C0[1],C1[0]),b=MX3(C0[2],C0[3],C1[1]); a=MX3(a,C1[2],C1[3]); \
      _Pragma("unroll") for(int r=4;r<16;r+=4){a=MX3(a,C0[r],C0[r+1]);b=MX3(b,C0[r+2],C0[r+3]);a=MX3(a,C1[r],C1[r+1]);b=MX3(b,C1[r+2],C1[r+3]);} \
      float rm=__builtin_fmaxf(a,b); { auto rr=__builtin_amdgcn_permlane32_swap(__float_as_uint(rm),__float_as_uint(rm),false,false); rm=__builtin_fmaxf(__uint_as_float(rr[0]),__uint_as_float(rr[1])); } \
      resc=false; \
      if(__builtin_expect(__any(rm>(float)THRL),0)){ const float dl=__builtin_fmaxf(rm,0.f); mhat+=dl; \
        _Pragma("unroll") for(int r=0;r<16;++r){C0[r]-=dl;C1[r]-=dl;} \
        _Pragma("unroll") for(int r=0;r<16;++r)negm[r]=-mhat; asm volatile("":"+v"(negm)); \
        const float f=__builtin_amdgcn_exp2f(-dl); l_reg*=f; if(hi==0)wsf[r32]=f; resc=true; } } \
    SBAR(); \
    GAPB(o[0]=MF32(PAF(0),VFR(0),o[0]), C0,0);  VRD2(0); \
    GAPB(o[1]=MF32(PAF(0),VFR(4),o[1]), C0,4);  VRD2(4); \
    KRD(GL,0); GAPB(o[0]=MF32(PAF(1),VFR(1),o[0]), C0,8);  VRD2(1); \
    KRD(GL,1); GAPB(o[1]=MF32(PAF(1),VFR(5),o[1]), C0,12); VRD2(5); \
    KRD(GL,2); GAPB(o[0]=MF32(PAF(2),VFR(2),o[0]), C1,0);  VRD2(2); \
    KRD(GL,3); GAPB(o[1]=MF32(PAF(2),VFR(6),o[1]), C1,4);  VRD2(6); \
    GAPB(o[0]=MF32(PAF(3),VFR(3),o[0]), C1,8);  VRD2(3); \
    GAPB(o[1]=MF32(PAF(3),VFR(7),o[1]), C1,12); VRD2(7); \
    float sacc=0.f; \
    GAPC(o[2]=MF32(PAF(0),VFR(0),o[2]), C0[0],C0[1],C0[2],C0[3]); \
    GAPC(o[3]=MF32(PAF(0),VFR(4),o[3]), C0[4],C0[5],C0[6],C0[7]);     pw0=(u32x4){PKW(C0,0),PKW(C0,2),PKW(C0,4),PKW(C0,6)}; PIN(pw0); SBAR(); \
    GAPC(o[2]=MF32(PAF(1),VFR(1),o[2]), C0[8],C0[9],C0[10],C0[11]); \
    GAPC(o[3]=MF32(PAF(1),VFR(5),o[3]), C0[12],C0[13],C0[14],C0[15]); pw1=(u32x4){PKW(C0,8),PKW(C0,10),PKW(C0,12),PKW(C0,14)}; PIN(pw1); SBAR(); \
    GAPC(o[2]=MF32(PAF(2),VFR(2),o[2]), C1[0],C1[1],C1[2],C1[3]); \
    GAPC(o[3]=MF32(PAF(2),VFR(6),o[3]), C1[4],C1[5],C1[6],C1[7]);     pw2=(u32x4){PKW(C1,0),PKW(C1,2),PKW(C1,4),PKW(C1,6)}; PIN(pw2); SBAR(); \
    GAPC(o[2]=MF32(PAF(3),VFR(3),o[2]), C1[8],C1[9],C1[10],C1[11]); \
    GAPC(o[3]=MF32(PAF(3),VFR(7),o[3]), C1[12],C1[13],C1[14],C1[15]); pw3=(u32x4){PKW(C1,8),PKW(C1,10),PKW(C1,12),PKW(C1,14)}; PIN(pw3); SBAR(); \
    l_reg+=sacc; \
    }while(0)
  int t=1;
  #undef CMASK
  #define CMASK(P0,P1,t) do{}while(0)
  for(;t+5<NT;t+=2){
    STEP(c0,c1,t,true,true,true);     WAIT_BAR(3); RESC(); ROT();
    STEP(c0,c1,t+1,true,true,true);   WAIT_BAR(3); RESC(); ROT();
  }
  #undef CMASK
  #define CMASK(P0,P1,t) do{int jb_=(t)-(NT-4); if(jb_>=0)cmask(P0,P1,jb_,qrel,hi);}while(0)
  #define ENDW(tt) do{ if((tt)+3<NT){WAIT_BAR(3);} else if((tt)+2<NT){WAIT_BAR(2);} else {WAIT_BAR(0);} }while(0)
  for(;t+1<NT;t+=2){
    STEP(c0,c1,t,(t+3<NT),(t+1<NT),(t+1<NT));       ENDW(t);   RESC(); ROT();
    STEP(c0,c1,t+1,(t+4<NT),(t+2<NT),(t+2<NT));     ENDW(t+1); RESC(); ROT();
  }
  STEP(c0,c1,NT-1,false,false,false); RESC();
  SBAR(); pv(o,vb0+2*sl_cur,PAF(0),PAF(1),PAF(2),PAF(3));
  #undef PKW
  #undef PAF
  #undef VFR
  #undef PIN
  #undef MX3
  #undef GAPB
  #undef GAPC
  #undef EX
  #undef VRD
  #undef VRD2
  #undef KRD
  #undef MF32
  #undef STEP
  #undef ENDW
  {auto rr=__builtin_amdgcn_permlane32_swap(__float_as_uint(l_reg),__float_as_uint(l_reg),false,false);l_reg=__uint_as_float(rr[0])+__uint_as_float(rr[1]);}
  { int le=lane; asm volatile("":"+v"(le)); const int r32e=le&31,hie=le>>5;
  float*wse=(float*)(shm+LDS_WS)+wid*64;
  if(hie==0)wse[32+r32e]=l_reg;asm volatile("s_waitcnt lgkmcnt(0)":::"memory");
  float rli[16];
  #pragma unroll
  for(int r=0;r<16;++r)rli[r]=__builtin_amdgcn_rcpf(wse[32+crow(r,hie)]);
  bf16*Ow=O+(rowbase+q0+wid*QBLK)*OP+ocol;
  { bf16*stg=(bf16*)(shm+LDS_OST)+wid*2048;
    #pragma unroll
    for(int hf=0;hf<2;++hf){
      #pragma unroll
      for(int r=0;r<16;++r){const int orow=crow(r,hie);
        #pragma unroll
        for(int d0=0;d0<2;++d0)stg[orow*64+d0*32+r32e]=__float2bfloat16(o[2*hf+d0][r]*rli[r]);}
      asm volatile("s_waitcnt lgkmcnt(0)":::"memory");
      #pragma unroll
      for(int i=0;i<4;++i){const int row=i*8+(le>>3),ch=le&7; const u32x4 v=*(const u32x4*)(stg+row*64+ch*8); ATTN_STORE16(Ow+(long)row*OP+hf*64+ch*8,v);}
      asm volatile("s_waitcnt lgkmcnt(0)":::"memory"); } } }
  asm volatile("s_waitcnt lgkmcnt(0)\n\ts_barrier":::"memory");
  #undef DMA_K
  #undef DMA_V
  #undef CMASK
  #undef START
  #undef RESC
  #undef ROT
}
constexpr int ATTN_LDS_BYTES=LDS_BYTES;
struct AttnTensors { const bf16* Q; const bf16* K; const bf16* V; bf16* O; bf16* O2; };
struct AttnUnit { int bh; int qb; };
struct StaticOrder {
  int vcu,G;
  __device__ __forceinline__ explicit StaticOrder(int grid,int v):vcu(v),G(grid){}
  __device__ __forceinline__ bool next(int i,AttnUnit&u)const{ const int p=vcu+(i>>1)*G; if(p>=BATCH*NVH*8)return false; const int s=p&7; u.bh=p>>3; u.qb=(i&1)?15-s:s; return true; }
  __device__ __forceinline__ void a_ready(const AttnUnit&)const{}
  __device__ __forceinline__ void done(const AttnUnit&)const{}
};
template<class Sched,int THRL=8> __device__ __forceinline__ void attn_phase(char*lds,const AttnTensors&T,const Sched&S){
  AttnUnit u;
  for(int i=0;S.next(i,u);++i){ S.a_ready(u); { const int b_=u.bh>>4,hc_=u.bh&15,h_=hc_>>1,c_=hc_&1; attn_unit<THRL>(b_,h_*128+c_*64,h_*128,h_*128,u.qb,T.Q,T.K,T.V,c_?T.O2:T.O,lds); } S.done(u); }
}
#undef SBAR
#undef WAIT_BAR
}
namespace cg = cooperative_groups;
constexpr int NWAVES = 8;
#ifndef MK_N_LAUNCHES
#define MK_N_LAUNCHES 1
#endif
constexpr int N_PHASES = 8;
constexpr int N_LAUNCHES = MK_N_LAUNCHES;

constexpr int BATCH = 16, T = 4096, D = 1024, NCOLS = 10240;
constexpr int M = BATCH * T;
constexpr float NORM_EPS = 1e-6f, HEAD_EPS = 1e-5f, LAM_INIT = 0.2f;

constexpr size_t MiB = 1u << 20;
constexpr size_t WS_WIN = 2 * MiB, WS_WA = 22 * MiB, WS_WB = 24 * MiB, WS_WO = 26 * MiB;
constexpr size_t WS_XN = 32 * MiB, WS_SB = 160 * MiB, WS_CX = 288 * MiB, WS_Q = 416 * MiB, WS_K = 544 * MiB, WS_V = 672 * MiB, WS_ZB = 800 * MiB, WS_END = 928 * MiB;
constexpr size_t WS_AA = WS_XN;
constexpr size_t WS_O1 = WS_CX, WS_O2 = WS_SB;
constexpr size_t WS_AB = WS_ZB;
constexpr size_t WS_MM = WS_K;

constexpr int RING_OFF = 0, RING_BYTES = 131072;
constexpr int LDS_BYTES = 147456;

#define GAS __attribute__((address_space(1)))
#define LAS __attribute__((address_space(3)))
typedef unsigned short bf16;
typedef unsigned v4u __attribute__((ext_vector_type(4)));
typedef float f32x4 __attribute__((ext_vector_type(4)));
#define LDS_WAIT() asm volatile("s_waitcnt lgkmcnt(0)" ::: "memory")
__device__ __forceinline__ unsigned f2bf(float f) { unsigned u = __builtin_bit_cast(unsigned, f); return (u + 0x7fffu + ((u >> 16) & 1u)) >> 16; }
__device__ __forceinline__ unsigned pk2(float lo, float hi) { return f2bf(lo) | (f2bf(hi) << 16); }
__device__ __forceinline__ float blo(unsigned w) { return __builtin_bit_cast(float, w << 16); }
__device__ __forceinline__ float bhi(unsigned w) { return __builtin_bit_cast(float, w & 0xffff0000u); }

#define XB_TMO      128
#define XB_XCNT(j)  (256  + 64 * (j))
#define XB_XSUB(j)  (1280 + 64 * (j))
#define XB_XGEN(j)  (2304 + 64 * (j))
#define XB_TOP      3328
#define XB_TOPGEN   3392
#define XCD_BAR_WORDS 3456
#define XB_SPIN_CAP (1u << 18)

__device__ __forceinline__ unsigned xb_ld(unsigned* p)              { return __hip_atomic_load(p, __ATOMIC_RELAXED, __HIP_MEMORY_SCOPE_AGENT); }
__device__ __forceinline__ unsigned xb_add(unsigned* p, unsigned v) { return __hip_atomic_fetch_add(p, v, __ATOMIC_RELAXED, __HIP_MEMORY_SCOPE_AGENT); }
__device__ __forceinline__ unsigned xb_xcc_id() { return (unsigned)__builtin_amdgcn_s_getreg((3 << 11) | 20) & 0xFu; }
#define XB_SPIN(cond, bar) do { unsigned _sp = 0; while (cond) { __builtin_amdgcn_s_sleep(1); \
    if ((++_sp & 255u) == 0u) { if (xb_ld(&(bar)[XB_TMO])) break; if (_sp > XB_SPIN_CAP) { atomicAdd(&(bar)[XB_TMO], 1u); break; } } } } while (0)

struct XcdBarrier {
    unsigned* bar; unsigned x;
    volatile LAS unsigned* st;
};

__device__ __forceinline__ XcdBarrier xcd_barrier_post(unsigned* bar, volatile LAS unsigned* st) {
    XcdBarrier b; b.bar = bar; b.x = xb_xcc_id(); b.st = st;
    if (threadIdx.x == 0) (void)xb_add(&bar[XB_XCNT(b.x)], 1u);
    return b;
}
__device__ __forceinline__ void xcd_barrier_complete(unsigned* bar, unsigned x, unsigned& nloc, unsigned& nx) {
    const unsigned G = gridDim.x * gridDim.y * gridDim.z;
    unsigned sum, cnt, mine, sp = 0u;
    for (;;) {
        sum = 0u; cnt = 0u; mine = 0u;
#pragma unroll
        for (unsigned j = 0; j < 16; ++j) { const unsigned c = xb_ld(&bar[XB_XCNT(j)]); sum += c; cnt += (c > 0u) ? 1u : 0u; mine = (j == x) ? c : mine; }
        if (sum == G) break;
        __builtin_amdgcn_s_sleep(1);
        if ((++sp & 255u) == 0u) { if (xb_ld(&bar[XB_TMO])) break; if (sp > XB_SPIN_CAP) { atomicAdd(&bar[XB_TMO], 1u); break; } }
    }
    nloc = mine > 0u ? mine : 1u; nx = cnt > 0u ? cnt : 1u;
}

__device__ __forceinline__ void xcd_barrier(const XcdBarrier& b) {
    asm volatile("s_waitcnt vmcnt(0)" ::: "memory");
    __syncthreads();
    if (threadIdx.x == 0) {
        unsigned* bar = b.bar;
        __builtin_amdgcn_s_waitcnt(0);
        unsigned nloc = b.st[0], nx = b.st[1];
        if (nloc == 0u) { xcd_barrier_complete(bar, b.x, nloc, nx); b.st[0] = nloc; b.st[1] = nx; }
        const unsigned old = xb_add(&bar[XB_XSUB(b.x)], 1u);
        const unsigned gen = old / nloc;
        if (old + 1u == (gen + 1u) * nloc) {
            __builtin_amdgcn_fence(__ATOMIC_RELEASE, "agent");
            asm volatile("s_waitcnt vmcnt(0)" ::: "memory");
            const unsigned og = xb_add(&bar[XB_TOP], 1u);
            const unsigned tg = og / nx;
            if (og + 1u == (tg + 1u) * nx) xb_add(&bar[XB_TOPGEN], 1u);
            else XB_SPIN(xb_ld(&bar[XB_TOPGEN]) == tg, bar);
            __builtin_amdgcn_fence(__ATOMIC_ACQUIRE, "agent");
            xb_add(&bar[XB_XGEN(b.x)], 1u);
            asm volatile("s_waitcnt vmcnt(0)" ::: "memory");
        } else {
            XB_SPIN(xb_ld(&bar[XB_XGEN(b.x)]) == gen, bar);
            __builtin_amdgcn_fence(__ATOMIC_ACQUIRE, "agent");
            asm volatile("s_waitcnt vmcnt(0)" ::: "memory");
        }
    }
    __syncthreads();
}

constexpr size_t WS_BAR = 0;
constexpr int MISC_OFF = RING_BYTES + 1024;
struct Frame {
    LAS unsigned char* lds;
    int tid, lane, wave, vcu, G;
};
__device__ __forceinline__ float wave_sum(float v) {
#pragma unroll
    for (int o = 1; o < 64; o <<= 1) v += __shfl_xor(v, o);
    return v;
}
__device__ __forceinline__ int win_dest_row(int n) {
    if (n >= 4096) return n;
    const int q = n >> 10, ch = n & 1023, pn = ch >> 6, c6 = ch & 63, wc = c6 >> 4, fq = (c6 >> 2) & 3, j = c6 & 3;
    return 256 * pn + 128 * (q >> 1) + 32 * wc + 8 * fq + 4 * (q & 1) + j;
}
template <bool PERMCONV>
__device__ __forceinline__ void p0_transpose_item(const float* W, int K, int N, bf16* WT, LAS float* scr, int item, int lane) {
    const int nblk = N / 32, kb = item / nblk, nb = item % nblk, k0 = 64 * kb, n0 = 32 * nb;
#pragma unroll 8
    for (int i = 0; i < 32; ++i) { const int kk = 2 * i + (lane >> 5); scr[kk * 33 + (lane & 31)] = W[(size_t)(k0 + kk) * N + n0 + (lane & 31)]; }
    LDS_WAIT(); asm volatile("" ::: "memory");
    const int c = lane & 7;
#pragma unroll
    for (int j = 0; j < 4; ++j) { const int n = (lane >> 3) + 8 * j; const LAS float* s = scr + (8 * c) * 33 + n;
        v4u o; o.x = pk2(s[0 * 33], s[1 * 33]); o.y = pk2(s[2 * 33], s[3 * 33]); o.z = pk2(s[4 * 33], s[5 * 33]); o.w = pk2(s[6 * 33], s[7 * 33]);
        const int dr = PERMCONV ? win_dest_row(n0 + n) : (n0 + n);
        *(GAS v4u*)(WT + (size_t)dr * K + k0 + 8 * c) = o; }
    LDS_WAIT(); asm volatile("" ::: "memory");
}
template <int NR>
__device__ __forceinline__ void rms_rows_to_bf16(int lane, const float* xrow, size_t rstride, const float* w, bf16* orow) {
    f32x4 v[NR][4]; float s2[NR];
#pragma unroll
    for (int r = 0; r < NR; ++r) { const GAS f32x4* xr = (const GAS f32x4*)(xrow + r * rstride) + lane;
#pragma unroll
        for (int j = 0; j < 4; ++j) v[r][j] = xr[64 * j]; }
    const GAS f32x4* wr = (const GAS f32x4*)w + lane; f32x4 ww[4];
#pragma unroll
    for (int j = 0; j < 4; ++j) ww[j] = wr[64 * j];
#pragma unroll
    for (int r = 0; r < NR; ++r) { s2[r] = 0.f;
#pragma unroll
        for (int j = 0; j < 4; ++j) s2[r] += (v[r][j].x * v[r][j].x + v[r][j].y * v[r][j].y) + (v[r][j].z * v[r][j].z + v[r][j].w * v[r][j].w); }
#pragma unroll
    for (int o = 1; o < 64; o <<= 1)
#pragma unroll
        for (int r = 0; r < NR; ++r) s2[r] += __shfl_xor(s2[r], o);
#pragma unroll
    for (int r = 0; r < NR; ++r) { const float rstd = 1.f / sqrtf(s2[r] * (1.f / D) + NORM_EPS);
        GAS unsigned long long* o8 = (GAS unsigned long long*)(orow + r * rstride) + lane;
#pragma unroll
        for (int j = 0; j < 4; ++j)
            o8[64 * j] = (unsigned long long)pk2(v[r][j].x * rstd * ww[j].x, v[r][j].y * rstd * ww[j].y) | ((unsigned long long)pk2(v[r][j].z * rstd * ww[j].z, v[r][j].w * rstd * ww[j].w) << 32); }
}
template <int NR>
__device__ __forceinline__ void rms_rows_f32(int lane, const float* xrow, size_t rstride, const float* w, float* orow) {
    f32x4 v[NR][4]; float s2[NR];
#pragma unroll
    for (int r = 0; r < NR; ++r) { const GAS f32x4* xr = (const GAS f32x4*)(xrow + r * rstride) + lane;
#pragma unroll
        for (int j = 0; j < 4; ++j) v[r][j] = xr[64 * j]; }
    const GAS f32x4* wr = (const GAS f32x4*)w + lane; f32x4 ww[4];
#pragma unroll
    for (int j = 0; j < 4; ++j) ww[j] = wr[64 * j];
#pragma unroll
    for (int r = 0; r < NR; ++r) { s2[r] = 0.f;
#pragma unroll
        for (int j = 0; j < 4; ++j) s2[r] += (v[r][j].x * v[r][j].x + v[r][j].y * v[r][j].y) + (v[r][j].z * v[r][j].z + v[r][j].w * v[r][j].w); }
#pragma unroll
    for (int o = 1; o < 64; o <<= 1)
#pragma unroll
        for (int r = 0; r < NR; ++r) s2[r] += __shfl_xor(s2[r], o);
#pragma unroll
    for (int r = 0; r < NR; ++r) { const float rstd = 1.f / sqrtf(s2[r] * (1.f / D) + NORM_EPS);
        GAS f32x4* o = (GAS f32x4*)(orow + r * rstride) + lane;
#pragma unroll
        for (int j = 0; j < 4; ++j) o[64 * j] = v[r][j] * rstd * ww[j]; }
}

struct Args { const float* in[14]; float* out; unsigned char* ws; int ph_lo, ph_hi; };
__device__ __forceinline__ int opq(int k) { asm volatile("" : "+s"(k)); return k; }
__device__ __forceinline__ size_t opq64(size_t k) { asm volatile("" : "+s"(k)); return k; }
__global__ void __launch_bounds__(NWAVES * 64, 2) hyb_fwd(Args args) {
    __builtin_assume(__builtin_amdgcn_workitem_id_y() == 0); __builtin_assume(__builtin_amdgcn_workitem_id_z() == 0);
    extern __shared__ __attribute__((aligned(16))) unsigned char lds[];
    Frame F;
    F.lds = (LAS unsigned char*)lds;
    F.tid = threadIdx.x; F.lane = F.tid & 63; F.wave = __builtin_amdgcn_readfirstlane(F.tid >> 6);
    F.G = gridDim.x; { const int bx = blockIdx.x; F.vcu = (F.G % 8 == 0) ? (bx % 8) * (F.G / 8) + bx / 8 : bx; }
#define KIN(k) (args.in[opq(k)])
#define WSP(off) ((bf16*)(args.ws + (size_t)opq64(off)))
    const int lo = args.ph_lo, hi = args.ph_hi;
#define IN(k) (lo <= (k) && (k) < hi)
#define SEAM(k) do { if (IN(k) && IN((k) + 1)) { \
        if ((k) == 0) { cg::this_grid().sync(); if (F.tid == 0) (void)xb_add((unsigned*)(args.ws + opq64(WS_BAR)) + XB_XCNT(xb_xcc_id()), 1u); } \
        else { XcdBarrier b_; b_.bar = (unsigned*)(args.ws + opq64(WS_BAR)); b_.x = xb_xcc_id(); b_.st = (volatile LAS unsigned*)(F.lds + MISC_OFF); xcd_barrier(b_); } } } while (0)
    const int gw = F.vcu * NWAVES + F.wave, NGW = F.G * NWAVES;
    if (F.tid < 2) ((volatile LAS unsigned*)(F.lds + MISC_OFF))[F.tid] = 0u;
    __syncthreads();

    if (IN(0)) {
        if (blockIdx.x == 0) { unsigned* bw = (unsigned*)(args.ws + opq64(WS_BAR)); for (int i = F.tid; i < XCD_BAR_WORDS; i += NWAVES * 64) __hip_atomic_store(bw + i, 0u, __ATOMIC_RELAXED, __HIP_MEMORY_SCOPE_AGENT); }
        LAS float* scr = (LAS float*)(F.lds + RING_OFF + F.wave * 16384);
        const float* x = KIN(0); const float* norm_w = KIN(1); const float* w_in = KIN(2); const float* w_out_a = KIN(4); const float* w_out_b = KIN(10); const float* w_o = KIN(12);
        bf16* Win_t = WSP(WS_WIN); bf16* Wa_t = WSP(WS_WA); bf16* Wb_t = WSP(WS_WB); bf16* Wo_t = WSP(WS_WO); bf16* XN = WSP(WS_XN);
        constexpr int I_IN = (D / 64) * (NCOLS / 32), I_SQ = (D / 64) * (D / 32);
        constexpr int NITEMS = I_IN + 3 * I_SQ;
        for (int it = gw; it < NITEMS; it += NGW) {
            int r = it;
            if (r < I_IN) { p0_transpose_item<true>(w_in, D, NCOLS, Win_t, scr, r, F.lane); continue; } r -= I_IN;
            if (r < I_SQ) { p0_transpose_item<false>(w_out_a, D, D, Wa_t, scr, r, F.lane); continue; } r -= I_SQ;
            if (r < I_SQ) { p0_transpose_item<false>(w_out_b, D, D, Wb_t, scr, r, F.lane); continue; } r -= I_SQ;
            p0_transpose_item<false>(w_o, D, D, Wo_t, scr, r, F.lane);
        }
        for (int m = gw; m < M; m += 4 * NGW) rms_rows_to_bf16<4>(F.lane, x + (size_t)m * D, (size_t)NGW * D, norm_w, XN + (size_t)m * D);
    }
    SEAM(0);
    if (IN(1)) {
        bf16* XN = WSP(WS_XN); bf16* Win_t = WSP(WS_WIN); bf16* CX = WSP(WS_CX); bf16* SB = WSP(WS_SB); bf16* QB_ = WSP(WS_Q); bf16* GT = (bf16*)args.out; const float* b_gate = KIN(11);
        pg8::Gemm g{XN, Win_t, M, NCOLS, D}; pg8::StaticOrder S; S.init(M, NCOLS, F.G, (int)blockIdx.x);
        pg8::EpiInProj E{CX, SB, QB_, (size_t)(WS_K - WS_Q) / 2, GT, b_gate, attn_body::C2};
        pg8::gemm_phase<pg8::EpiInProj, pg8::StaticOrder, PG8_ALIGN, PG8_SP2>(F.lds + RING_OFF, g, S, E);
    }
    SEAM(1);
    if (IN(2)) {
        const int cgp = F.tid & 127, rs = F.tid >> 7, ch = cgp * 8;
        const float* conv_w = KIN(3); bf16* CX = WSP(WS_CX); bf16* SB = WSP(WS_SB); bf16* AA = WSP(WS_AA);
        float w0[8], w1[8], w2[8];
#pragma unroll
        for (int e = 0; e < 8; ++e) { w0[e] = conv_w[ch + e]; w1[e] = conv_w[1024 + ch + e]; w2[e] = conv_w[2048 + ch + e]; }
        for (int item = F.vcu; item < M / 64; item += F.G) {
            const int r0 = item * 64 + rs * 16;
            const bool first = (r0 % T) == 0;
            v4u p2 = (v4u){0u, 0u, 0u, 0u}, p1 = (v4u){0u, 0u, 0u, 0u};
            if (!first) { p2 = *(const GAS v4u*)(CX + (size_t)(r0 - 2) * 1024 + ch); p1 = *(const GAS v4u*)(CX + (size_t)(r0 - 1) * 1024 + ch); }
#pragma unroll
            for (int hb = 0; hb < 2; ++hb) {
                v4u c[8], s[8];
#pragma unroll
                for (int i = 0; i < 8; ++i) { c[i] = *(const GAS v4u*)(CX + (size_t)(r0 + hb * 8 + i) * 1024 + ch); s[i] = *(const GAS v4u*)(SB + (size_t)(r0 + hb * 8 + i) * 1024 + ch); }
#pragma unroll
                for (int i = 0; i < 8; ++i) {
                    const v4u cur = c[i]; v4u o;
#pragma unroll
                    for (int q = 0; q < 4; ++q) {
                        const float ylo = w0[2 * q] * blo(p2[q]) + w1[2 * q] * blo(p1[q]) + w2[2 * q] * blo(cur[q]);
                        const float yhi = w0[2 * q + 1] * bhi(p2[q]) + w1[2 * q + 1] * bhi(p1[q]) + w2[2 * q + 1] * bhi(cur[q]);
                        o[q] = pk2(ylo * blo(s[i][q]), yhi * bhi(s[i][q]));
                    }
                    *(GAS v4u*)(AA + (size_t)(r0 + hb * 8 + i) * 1024 + ch) = o;
                    p2 = p1; p1 = cur;
                }
            }
        }
    }
    SEAM(2);
    if (IN(3)) {
        bf16* QB_ = WSP(WS_Q); bf16* KB = WSP(WS_K); bf16* VB = WSP(WS_V); bf16* O1 = WSP(WS_O1); bf16* O2 = WSP(WS_O2);
        const attn_body::AttnTensors AT{(const attn_body::bf16*)QB_, (const attn_body::bf16*)KB, (const attn_body::bf16*)VB, (attn_body::bf16*)O1, (attn_body::bf16*)O2};
        const attn_body::StaticOrder S((int)F.G, F.vcu);
        attn_body::attn_phase<attn_body::StaticOrder>((char*)lds + RING_OFF, AT, S);
    }
    SEAM(3);
    if (IN(4)) {
        const float* lq1 = KIN(5); const float* lk1 = KIN(6); const float* lq2 = KIN(7); const float* lk2 = KIN(8); const float* head_w = KIN(9);
        bf16* O1 = WSP(WS_O1); bf16* O2 = WSP(WS_O2); bf16* ZB = WSP(WS_ZB); bf16* AB = WSP(WS_AB);
        const float d1 = lq1[F.lane] * lk1[F.lane], d2 = lq2[F.lane] * lk2[F.lane];
        const float lam = __expf(wave_sum(d1)) - __expf(wave_sum(d2)) + LAM_INIT;
        const int rsub = F.tid >> 7, l = F.tid & 127, h = l >> 4, j0 = (l & 15) * 8;
        float hw[8];
#pragma unroll
        for (int e = 0; e < 8; ++e) hw[e] = head_w[j0 + e] * (1.0f - LAM_INIT);
        for (int item = F.vcu; item < M / 32; item += F.G) {
#pragma unroll 2
            for (int ps = 0; ps < 8; ++ps) {
                const size_t row = (size_t)item * 32 + ps * 4 + rsub;
                const v4u o1 = *(const GAS v4u*)(O1 + row * 1024 + h * 128 + j0), o2 = *(const GAS v4u*)(O2 + row * 1024 + h * 128 + j0);
                const v4u z = *(const GAS v4u*)(ZB + row * 1024 + h * 128 + j0);
                float d[8]; float ss = 0.f;
#pragma unroll
                for (int q = 0; q < 4; ++q) { d[2 * q] = blo(o1[q]) - lam * blo(o2[q]); d[2 * q + 1] = bhi(o1[q]) - lam * bhi(o2[q]); ss += d[2 * q] * d[2 * q] + d[2 * q + 1] * d[2 * q + 1]; }
                ss += __shfl_xor(ss, 1); ss += __shfl_xor(ss, 2); ss += __shfl_xor(ss, 4); ss += __shfl_xor(ss, 8);
                const float rstd = 1.f / sqrtf(ss * (1.f / 128.f) + HEAD_EPS);
                v4u o;
#pragma unroll
                for (int q = 0; q < 4; ++q) o[q] = pk2(d[2 * q] * rstd * hw[2 * q] * pg8::silu_f(blo(z[q])), d[2 * q + 1] * rstd * hw[2 * q + 1] * pg8::silu_f(bhi(z[q])));
                *(GAS v4u*)(AB + row * 1024 + h * 128 + j0) = o;
            }
        }
    }
    SEAM(4);
    if (IN(5)) {
        bf16* AA = WSP(WS_AA); bf16* Wa_t = WSP(WS_WA); bf16* AB = WSP(WS_AB); bf16* Wb_t = WSP(WS_WB); bf16* MM = WSP(WS_MM); bf16* GT = (bf16*)args.out;
        pg8::Gemm g{AA, Wa_t, M, D, D, AB, Wb_t}; pg8::DualOrder S; S.init(M, D, F.G, (int)blockIdx.x);
        pg8::EpiDual E{MM, GT};
        pg8::gemm_phase<pg8::EpiDual, pg8::DualOrder, PG8_ALIGN, PG8_SP2>(F.lds + RING_OFF, g, S, E);
    }
    SEAM(5);
    if (IN(6)) {
        bf16* MM = WSP(WS_MM); bf16* Wo_t = WSP(WS_WO); float* out = args.out; const float* x = KIN(0);
        pg8::Gemm g{MM, Wo_t, M, D, D}; pg8::StaticOrder S; S.init(M, D, F.G, (int)blockIdx.x);
        pg8::EpiResF32 E{out, x};
        pg8::gemm_phase<pg8::EpiResF32, pg8::StaticOrder, PG8_ALIGN, PG8_SP2>(F.lds + RING_OFF, g, S, E);
    }
    SEAM(6);
    if (IN(7)) {
        float* out = args.out; const float* final_w = KIN(13);
        for (int m = gw; m < M; m += 4 * NGW) rms_rows_f32<4>(F.lane, out + (size_t)m * D, (size_t)NGW * D, final_w, out + (size_t)m * D);
    }
#undef IN
#undef SEAM
}

extern "C" void kernel_launch(void* const* d_in, const int* in_sizes, int n_in, void* d_out, int out_size, void* d_ws, size_t ws_size, hipStream_t stream) {
    static int grid = 0;
    if (grid == 0) {
        if (n_in != 14 || in_sizes[0] != M * D || out_size != M * D || ws_size < WS_END) { fprintf(stderr, "kernel_launch: unexpected shapes: n_in %d in0 %d out %d ws %zu\n", n_in, n_in > 0 ? in_sizes[0] : -1, out_size, ws_size); grid = -1; return; }
        int dev = 0, cus = 0, per_cu = 0;
        if (hipGetDevice(&dev) != hipSuccess || hipDeviceGetAttribute(&cus, hipDeviceAttributeMultiprocessorCount, dev) != hipSuccess) { grid = -1; return; }
        if (hipFuncSetAttribute((const void*)hyb_fwd, hipFuncAttributeMaxDynamicSharedMemorySize, LDS_BYTES) != hipSuccess) { fprintf(stderr, "kernel_launch: hipFuncSetAttribute failed\n"); grid = -1; return; }
        if (hipOccupancyMaxActiveBlocksPerMultiprocessor(&per_cu, (const void*)hyb_fwd, NWAVES * 64, LDS_BYTES) != hipSuccess || per_cu < 1) { fprintf(stderr, "kernel_launch: occupancy query says %d\n", per_cu); per_cu = 1; }
        (void)hipGetLastError();
        grid = cus;
    }
    if (grid < 0) return;
    Args a{};
    for (int i = 0; i < 14; ++i) a.in[i] = (const float*)d_in[i];
    a.out = (float*)d_out; a.ws = (unsigned char*)d_ws;
    if (N_LAUNCHES == 1) {
        a.ph_lo = 0; a.ph_hi = N_PHASES;
        void* kargs[] = {&a};
        const hipError_t e = hipLaunchCooperativeKernel((const void*)hyb_fwd, dim3(grid), dim3(NWAVES * 64), kargs, LDS_BYTES, stream);
        if (e != hipSuccess) fprintf(stderr, "kernel_launch: cooperative launch failed: %s (grid %d)\n", hipGetErrorString(e), grid);
    } else {
        for (int li = 0; li < N_PHASES; ++li) {
            a.ph_lo = li; a.ph_hi = li + 1;
            hipLaunchKernelGGL(hyb_fwd, dim3(grid), dim3(NWAVES * 64), LDS_BYTES, stream, a);
        }
    }
}
```
